# Optimizing an MI355X kernel written in HIP

```python
import math
import jax, jax.numpy as jnp
from jax import lax
import numpy as np

D_MODEL = 1024
BATCH = 8
SEQ = 4096
DEPTH = 2

CHUNK = 64
EPS = 1e-6
D_FF = 4 * D_MODEL

SSD_HEADS = 16
SSD_HEAD_DIM = 64
SSD_INNER = SSD_HEADS * SSD_HEAD_DIM
SSD_GROUPS = 2
SSD_STATE = 128
SSD_CONV = 4
SSD_CONV_DIM = SSD_INNER + 2 * SSD_GROUPS * SSD_STATE
DT_MIN = 0.001
DT_MAX = 0.1

SWA_HEADS = 16
SWA_KV_HEADS = 4
SWA_HEAD_DIM = 64
SWA_WINDOW = 128
SWA_BLOCK = 128
SWA_WINDOW_CHUNKS = SWA_WINDOW // CHUNK

EVEN_IN = SSD_INNER + SSD_CONV_DIM + SSD_HEADS + (SWA_HEADS + 2 * SWA_KV_HEADS) * SWA_HEAD_DIM
EVEN_MIX = SSD_INNER + SWA_HEADS * SWA_HEAD_DIM

DIFF_HEADS = 8
DIFF_HEAD_DIM = 64
DIFF_MIX = 2 * DIFF_HEADS * DIFF_HEAD_DIM
DIFF_IN = 3 * DIFF_MIX
Q_BLOCK = 128

N_EVEN = (DEPTH + 1) // 2
N_ODD = DEPTH // 2

kernel_name = 'hybrid_ssd_swa_diffattn_trunk'


def rms_norm(x, w):
    xf = x.astype(jnp.float32)
    y = xf * lax.rsqrt(jnp.mean(xf * xf, axis=-1, keepdims=True) + EPS)
    return (y * w.astype(jnp.float32)).astype(x.dtype)


def alibi_slopes(n):
    return 2.0 ** (-8.0 * jnp.arange(1, n + 1, dtype=jnp.float32) / n)


def causal_depthwise_conv(x, w, b):
    k = w.shape[0]
    y = lax.conv_general_dilated(x, w[:, None, :].astype(x.dtype), window_strides=(1,),
                                 padding=((k - 1, 0),), dimension_numbers=('NWC', 'WIO', 'NWC'),
                                 feature_group_count=x.shape[-1])
    return y + b


def ssd_scan(x, dt, a, b_mat, c_mat):
    bsz, t, h, p = x.shape
    g, n = b_mat.shape[-2:]
    e = h // g
    nc = t // CHUNK
    f32 = jnp.float32
    xdt = (x.astype(f32) * dt[..., None]).reshape(bsz, nc, CHUNK, g, e, p)
    bm = b_mat.astype(f32).reshape(bsz, nc, CHUNK, g, n)
    cm = c_mat.astype(f32).reshape(bsz, nc, CHUNK, g, n)
    a_dt = (dt * a).reshape(bsz, nc, CHUNK, g, e).transpose(0, 3, 4, 1, 2)
    a_cum = jnp.cumsum(a_dt, axis=-1)
    seg = a_cum[..., :, None] - a_cum[..., None, :]
    causal = jnp.tril(jnp.ones((CHUNK, CHUNK), dtype=bool))
    decay = jnp.exp(jnp.where(causal, seg, -jnp.inf))
    cb = jnp.einsum('bclgn,bcsgn->bgcls', cm, bm)
    y_diag = jnp.einsum('bgecls,bcsgep->bclgep', cb[:, :, None] * decay, xdt)
    decay_to_end = jnp.exp(a_cum[..., -1:] - a_cum).transpose(0, 3, 4, 1, 2)
    chunk_states = jnp.einsum('bclgn,bclgep->cbgepn', bm, xdt * decay_to_end[..., None])
    chunk_decay = jnp.exp(a_cum[..., -1]).transpose(3, 0, 1, 2)

    def step(state, inp):
        dec, new = inp
        return state * dec[..., None, None] + new, state

    init = jnp.zeros((bsz, g, e, p, n), f32)
    _, prev = lax.scan(step, init, (chunk_decay, chunk_states))
    decay_in = jnp.exp(a_cum).transpose(0, 3, 4, 1, 2)
    y_off = jnp.einsum('bclgn,cbgepn->bclgep', cm, prev) * decay_in[..., None]
    return (y_diag + y_off).reshape(bsz, t, h, p)


def swa_attention(q, k, v, q_norm, k_norm, sinks):
    bsz, t = q.shape[:2]
    nb = t // SWA_BLOCK
    r = SWA_HEADS // SWA_KV_HEADS
    f32 = jnp.float32
    q = rms_norm(q, q_norm).reshape(bsz, nb, SWA_BLOCK, SWA_KV_HEADS, r, SWA_HEAD_DIM)
    k = rms_norm(k, k_norm)

    def band(z):
        zb = z.reshape(bsz, nb, SWA_BLOCK, SWA_KV_HEADS, SWA_HEAD_DIM)
        prev = jnp.pad(zb[:, :-1], ((0, 0), (1, 0), (0, 0), (0, 0), (0, 0)))
        return jnp.concatenate([prev, zb], axis=2)

    kb, vb = band(k), band(v)
    s = jnp.einsum('bnqhrd,bnkhd->bhrnqk', q, kb, preferred_element_type=f32) * (SWA_HEAD_DIM ** -0.5)
    qpos = jnp.arange(t).reshape(nb, SWA_BLOCK)
    kpos = qpos[:, :1] - SWA_BLOCK + jnp.arange(2 * SWA_BLOCK)
    dchunk = qpos[:, :, None] // CHUNK - kpos[:, None, :] // CHUNK
    valid = (kpos[:, None, :] >= 0) & (dchunk >= 0) & (dchunk <= SWA_WINDOW_CHUNKS)
    dist = jnp.abs(qpos[:, :, None] - kpos[:, None, :]).astype(f32)
    slopes = alibi_slopes(SWA_HEADS).reshape(1, SWA_KV_HEADS, r, 1, 1, 1)
    s = jnp.where(valid, s - slopes * dist, -jnp.inf)
    sink = sinks.astype(f32).reshape(1, SWA_KV_HEADS, r, 1, 1)
    m = jnp.maximum(jnp.max(s, axis=-1), sink)
    ex = jnp.exp(s - m[..., None])
    prob = ex / (jnp.sum(ex, axis=-1, keepdims=True) + jnp.exp(sink - m)[..., None])
    o = jnp.einsum('bhrnqk,bnkhd->bnqhrd', prob.astype(v.dtype), vb)
    return o.reshape(bsz, t, SWA_HEADS * SWA_HEAD_DIM)


def even_mixer(h, w_in, conv_w, conv_b, dt_bias, a_log, d_skip, ssd_norm_w, q_norm, k_norm, sinks, w_out):
    bsz, t, _ = h.shape
    proj = h @ w_in
    cuts = [SSD_INNER, SSD_INNER + SSD_CONV_DIM, SSD_INNER + SSD_CONV_DIM + SSD_HEADS,
            SSD_INNER + SSD_CONV_DIM + SSD_HEADS + SWA_HEADS * SWA_HEAD_DIM,
            SSD_INNER + SSD_CONV_DIM + SSD_HEADS + (SWA_HEADS + SWA_KV_HEADS) * SWA_HEAD_DIM]
    z, xbc, dt_raw, q, k, v = jnp.split(proj, cuts, axis=-1)
    xbc = jax.nn.silu(causal_depthwise_conv(xbc, conv_w, conv_b))
    xs, bm, cm = jnp.split(xbc, [SSD_INNER, SSD_INNER + SSD_GROUPS * SSD_STATE], axis=-1)
    xs = xs.reshape(bsz, t, SSD_HEADS, SSD_HEAD_DIM)
    dt = jax.nn.softplus(dt_raw.astype(jnp.float32) + dt_bias.astype(jnp.float32))
    a = -jnp.exp(a_log.astype(jnp.float32))
    y = ssd_scan(xs, dt, a, bm.reshape(bsz, t, SSD_GROUPS, SSD_STATE), cm.reshape(bsz, t, SSD_GROUPS, SSD_STATE))
    y = y + xs.astype(jnp.float32) * d_skip.astype(jnp.float32)[:, None]
    y = y.reshape(bsz, t, SSD_INNER) * jax.nn.silu(z.astype(jnp.float32))
    y = rms_norm(y.reshape(bsz, t, SSD_GROUPS, SSD_INNER // SSD_GROUPS), ssd_norm_w.reshape(SSD_GROUPS, -1))
    y_ssd = y.reshape(bsz, t, SSD_INNER).astype(h.dtype)
    y_swa = swa_attention(q.reshape(bsz, t, SWA_HEADS, SWA_HEAD_DIM),
                          k.reshape(bsz, t, SWA_KV_HEADS, SWA_HEAD_DIM),
                          v.reshape(bsz, t, SWA_KV_HEADS, SWA_HEAD_DIM), q_norm, k_norm, sinks).astype(h.dtype)
    return jnp.concatenate([y_ssd, y_swa], axis=-1) @ w_out


def diff_attention(h, w_in, q_norm, k_norm, lam_q1, lam_k1, lam_q2, lam_k2, sub_norm, w_out, layer_idx):
    bsz, t, _ = h.shape
    f32 = jnp.float32
    q, k, v = jnp.split(h @ w_in, 3, axis=-1)
    q = rms_norm(q.reshape(bsz, t, DIFF_HEADS, 2, DIFF_HEAD_DIM), q_norm)
    k = rms_norm(k.reshape(bsz, t, DIFF_HEADS, 2, DIFF_HEAD_DIM), k_norm)
    v = v.reshape(bsz, t, DIFF_HEADS, 2 * DIFF_HEAD_DIM)
    lam_init = 0.8 - 0.6 * math.exp(-0.3 * layer_idx)
    lam = (jnp.exp(jnp.sum(lam_q1.astype(f32) * lam_k1.astype(f32)))
           - jnp.exp(jnp.sum(lam_q2.astype(f32) * lam_k2.astype(f32))) + lam_init)
    slopes = alibi_slopes(DIFF_HEADS)[None, :, None, None, None]
    scale = DIFF_HEAD_DIM ** -0.5
    outs = []
    for i in range(t // Q_BLOCK):
        q0 = i * Q_BLOCK
        kend = q0 + Q_BLOCK
        s = jnp.einsum('bqhmd,bkhmd->bhmqk', q[:, q0:kend], k[:, :kend], preferred_element_type=f32) * scale
        qpos = q0 + jnp.arange(Q_BLOCK)
        kpos = jnp.arange(kend)
        dist = jnp.abs(qpos[:, None] - kpos[None, :]).astype(f32)
        mask = (kpos[None, :] // CHUNK) <= (qpos[:, None] // CHUNK)
        s = jnp.where(mask, s - slopes * dist, -jnp.inf)
        prob = jax.nn.softmax(s, axis=-1)
        attn = prob[:, :, 0] - lam * prob[:, :, 1]
        outs.append(jnp.einsum('bhqk,bkhd->bqhd', attn.astype(v.dtype), v[:, :kend]))
    o = jnp.concatenate(outs, axis=1)
    o = (rms_norm(o, sub_norm).astype(f32) * (1.0 - lam_init)).astype(h.dtype)
    return o.reshape(bsz, t, DIFF_MIX) @ w_out


def setup_inputs(seed: int = 0) -> dict:
    key = jax.random.key(seed)
    ks = iter(jax.random.split(key, 32))

    def nrm(shape, scale):
        return scale * jax.random.normal(next(ks), shape, jnp.float32)

    x = nrm((BATCH, SEQ, D_MODEL), 1.0)
    ev_norm_w = 1.0 + nrm((N_EVEN, D_MODEL), 0.02)
    ev_w_in = nrm((N_EVEN, D_MODEL, EVEN_IN), D_MODEL ** -0.5)
    ev_conv_w = nrm((N_EVEN, SSD_CONV, SSD_CONV_DIM), SSD_CONV ** -0.5)
    ev_conv_b = nrm((N_EVEN, SSD_CONV_DIM), 0.02)
    u = jax.random.uniform(next(ks), (N_EVEN, SSD_HEADS), jnp.float32)
    dt0 = jnp.maximum(jnp.exp(u * (math.log(DT_MAX) - math.log(DT_MIN)) + math.log(DT_MIN)), 1e-4)
    ev_dt_bias = dt0 + jnp.log(-jnp.expm1(-dt0))
    ev_a_log = jnp.log(jax.random.uniform(next(ks), (N_EVEN, SSD_HEADS), jnp.float32, 1.0, 16.0))
    ev_d_skip = 1.0 + nrm((N_EVEN, SSD_HEADS), 0.02)
    ev_ssd_norm_w = 1.0 + nrm((N_EVEN, SSD_INNER), 0.02)
    ev_q_norm = 1.0 + nrm((N_EVEN, SWA_HEAD_DIM), 0.02)
    ev_k_norm = 1.0 + nrm((N_EVEN, SWA_HEAD_DIM), 0.02)
    ev_sinks = nrm((N_EVEN, SWA_HEADS), 0.5)
    ev_w_out = nrm((N_EVEN, EVEN_MIX, D_MODEL), EVEN_MIX ** -0.5)
    od_norm_w = 1.0 + nrm((N_ODD, D_MODEL), 0.02)
    od_w_in = nrm((N_ODD, D_MODEL, DIFF_IN), D_MODEL ** -0.5)
    od_q_norm = 1.0 + nrm((N_ODD, DIFF_HEAD_DIM), 0.02)
    od_k_norm = 1.0 + nrm((N_ODD, DIFF_HEAD_DIM), 0.02)
    od_lam_q1 = nrm((N_ODD, DIFF_HEAD_DIM), 0.1)
    od_lam_k1 = nrm((N_ODD, DIFF_HEAD_DIM), 0.1)
    od_lam_q2 = nrm((N_ODD, DIFF_HEAD_DIM), 0.1)
    od_lam_k2 = nrm((N_ODD, DIFF_HEAD_DIM), 0.1)
    od_sub_norm = 1.0 + nrm((N_ODD, 2 * DIFF_HEAD_DIM), 0.02)
    od_w_out = nrm((N_ODD, DIFF_MIX, D_MODEL), DIFF_MIX ** -0.5)
    mlp_norm_w = 1.0 + nrm((DEPTH, D_MODEL), 0.02)
    mlp_w1 = nrm((DEPTH, D_MODEL, D_FF), D_MODEL ** -0.5)
    mlp_w2 = nrm((DEPTH, D_FF, D_MODEL), D_FF ** -0.5)
    return {'x': x, 'ev_norm_w': ev_norm_w, 'ev_w_in': ev_w_in, 'ev_conv_w': ev_conv_w, 'ev_conv_b': ev_conv_b,
            'ev_dt_bias': ev_dt_bias, 'ev_a_log': ev_a_log, 'ev_d_skip': ev_d_skip, 'ev_ssd_norm_w': ev_ssd_norm_w,
            'ev_q_norm': ev_q_norm, 'ev_k_norm': ev_k_norm, 'ev_sinks': ev_sinks, 'ev_w_out': ev_w_out,
            'od_norm_w': od_norm_w, 'od_w_in': od_w_in, 'od_q_norm': od_q_norm, 'od_k_norm': od_k_norm,
            'od_lam_q1': od_lam_q1, 'od_lam_k1': od_lam_k1, 'od_lam_q2': od_lam_q2, 'od_lam_k2': od_lam_k2,
            'od_sub_norm': od_sub_norm, 'od_w_out': od_w_out,
            'mlp_norm_w': mlp_norm_w, 'mlp_w1': mlp_w1, 'mlp_w2': mlp_w2}


def reference(x, ev_norm_w, ev_w_in, ev_conv_w, ev_conv_b, ev_dt_bias, ev_a_log, ev_d_skip, ev_ssd_norm_w,
              ev_q_norm, ev_k_norm, ev_sinks, ev_w_out,
              od_norm_w, od_w_in, od_q_norm, od_k_norm, od_lam_q1, od_lam_k1, od_lam_q2, od_lam_k2,
              od_sub_norm, od_w_out, mlp_norm_w, mlp_w1, mlp_w2):
    for layer in range(DEPTH):
        j = layer // 2
        if layer % 2 == 0:
            mix = even_mixer(rms_norm(x, ev_norm_w[j]), ev_w_in[j], ev_conv_w[j], ev_conv_b[j], ev_dt_bias[j],
                             ev_a_log[j], ev_d_skip[j], ev_ssd_norm_w[j], ev_q_norm[j], ev_k_norm[j],
                             ev_sinks[j], ev_w_out[j])
        else:
            mix = diff_attention(rms_norm(x, od_norm_w[j]), od_w_in[j], od_q_norm[j], od_k_norm[j],
                                 od_lam_q1[j], od_lam_k1[j], od_lam_q2[j], od_lam_k2[j],
                                 od_sub_norm[j], od_w_out[j], layer)
        x = x + mix.astype(x.dtype)
        hid = rms_norm(x, mlp_norm_w[layer]) @ mlp_w1[layer]
        x = x + (jnp.square(jax.nn.relu(hid)) @ mlp_w2[layer]).astype(x.dtype)
    return x
```

```cpp
#include <hip/hip_runtime.h>
#include <hip/hip_cooperative_groups.h>
#include <cstdio>
#include <cstdint>
namespace cg = cooperative_groups;
namespace pg8 {
#define PG8_LAS __attribute__((address_space(3)))
typedef unsigned short bf16_t;
typedef short bf16x8 __attribute__((ext_vector_type(8)));
typedef float f32x4 __attribute__((ext_vector_type(4)));
typedef unsigned u32x4 __attribute__((ext_vector_type(4)));
constexpr int BM = 256, BK = 64, HALF = 128, HTB = HALF * BK * 2  , STAGE_BYTES = 8 * HTB, NXCD = 8, WGM = 8;

__host__ __device__ __forceinline__ int lds_byte(int r, int c) { const int st = (r >> 4) * 2 + (c >> 5), rr = r & 15, cc = c & 31, ob = rr * 64 + cc * 2; return st * 1024 + (ob ^ (((ob >> 9) & 1) << 5)); }
__host__ __device__ __forceinline__ void stage_rc(int b, int& R, int& C) { const int st = b / 1024, sb = b % 1024, swz = sb ^ (((sb >> 9) & 1) << 5); R = (st >> 1) * 16 + swz / 64; C = (st & 1) * 32 + (swz % 64) / 2; }
__host__ __device__ __forceinline__ int perm32(int rho) { const int n = rho >> 4, i = rho & 15; return 8 * (i >> 2) + 4 * n + (i & 3); }

struct Unit { int pm, pn; };
struct Gemm { const bf16_t* A; const bf16_t* Bt; int M, N, K; };

struct StaticOrder {
    int nM, nN, nwg, G, c;
    __host__ __device__ void init(int M, int N, int G_, int c_) { nM = M / BM; nN = N / BM; nwg = nM * nN; G = G_; c = c_; }
    __host__ __device__ bool next(int i, Unit& u) const {
        const long L = (long)i * G + c; if (L >= nwg) return false;
        int wgid = (int)L; { const int q = nwg / NXCD, r = nwg % NXCD, xcd = wgid % NXCD, off = wgid / NXCD; wgid = (xcd < r ? xcd * (q + 1) : r * (q + 1) + (xcd - r) * q) + off; }
        const int nig = WGM * nN, gid = wgid / nig, fm = gid * WGM, gsz = (nM - fm) < WGM ? (nM - fm) : WGM;
        u.pm = fm + ((wgid % nig) % gsz); u.pn = (wgid % nig) / gsz; return true;
    }
    __device__ __forceinline__ void a_ready(const Unit&) const {}
    __device__ __forceinline__ void done(const Unit&) const {}
};

__device__ __forceinline__ unsigned cvt_pk_bf16(float lo, float hi) { unsigned r; asm volatile("v_cvt_pk_bf16_f32 %0, %1, %2" : "=v"(r) : "v"(lo), "v"(hi)); return r; }
template <int ACT, int NRM> struct EpiStore {
    static constexpr bool PERM = true, AFTER_DRAIN = false;
    bf16_t* O; int ldc; int ncols; const float* ssq; float* dtb; const float* qw; const float* kw;
    __device__ __forceinline__ void operator()(const f32x4 (&acc)[2][2][4][2], const Unit& u, int wr, int wc, int fr, int fq) const {
        const int row0 = u.pm * BM + wr * 64 + fr;
        constexpr bool NOSCALE = (ACT == 1 && NRM == 0);
        float sq[2][4];
#pragma unroll
        for (int ai = 0; ai < 2; ++ai)
#pragma unroll
            for (int m = 0; m < 4; ++m) sq[ai][m] = NOSCALE ? 0.f : ssq[row0 + ai * HALF + m * 16];
        if constexpr (NRM == 0) {
            const int col0 = u.pn * BM + wc * 32 + 8 * fq;
#pragma unroll
            for (int ai = 0; ai < 2; ++ai)
#pragma unroll
                for (int m = 0; m < 4; ++m) { const int row = row0 + ai * HALF + m * 16; const float rs = NOSCALE ? 1.0f : rsqrtf(sq[ai][m] * (1.0f / 1024.0f) + 1e-6f);
                    bf16_t* rowp = O + (size_t)row * ldc;
#pragma unroll
                    for (int bj = 0; bj < 2; ++bj) { const int col = col0 + bj * HALF;
                        if (col < ncols) { f32x4 v0 = acc[ai][bj][m][0] * rs, v1 = acc[ai][bj][m][1] * rs;
                            if (ACT) { v0 = __builtin_elementwise_max(v0, (f32x4){0.f, 0.f, 0.f, 0.f}); v1 = __builtin_elementwise_max(v1, (f32x4){0.f, 0.f, 0.f, 0.f}); v0 = v0 * v0; v1 = v1 * v1; }
                            u32x4 w; w.x = cvt_pk_bf16(v0[0], v0[1]); w.y = cvt_pk_bf16(v0[2], v0[3]); w.z = cvt_pk_bf16(v1[0], v1[1]); w.w = cvt_pk_bf16(v1[2], v1[3]);
                            *(u32x4*)(rowp + col) = w; } } }
        } else {
            const int gbase = u.pn * BM + 64 * wc;
            int kind = 0;
            if (NRM == 1) kind = (gbase >= 2560 && gbase < 3584) ? 1 : ((gbase >= 3584 && gbase < 3840) ? 2 : 0);
            else kind = gbase < 1024 ? 1 : (gbase < 2048 ? 2 : 0);
            f32x4 wg[2][2];
#pragma unroll
            for (int bj = 0; bj < 2; ++bj)
#pragma unroll
                for (int n = 0; n < 2; ++n) wg[bj][n] = kind ? *(const f32x4*)((kind == 1 ? qw : kw) + 32 * bj + 8 * fq + 4 * n) : (f32x4){1.f, 1.f, 1.f, 1.f};
            const float post = kind == 1 ? 0.125f * 1.4426950408889634f : 1.0f;
#pragma unroll
            for (int ai = 0; ai < 2; ++ai)
#pragma unroll
                for (int m = 0; m < 4; ++m) { const int row = row0 + ai * HALF + m * 16; const float rs = rsqrtf(sq[ai][m] * (1.0f / 1024.0f) + 1e-6f);
                    bf16_t* rowp = O + (size_t)row * ldc;
                    f32x4 v[2][2]; float ss = 0.f;
#pragma unroll
                    for (int bj = 0; bj < 2; ++bj)
#pragma unroll
                        for (int n = 0; n < 2; ++n) { v[bj][n] = acc[ai][bj][m][n] * rs; ss += (v[bj][n][0] * v[bj][n][0] + v[bj][n][1] * v[bj][n][1]) + (v[bj][n][2] * v[bj][n][2] + v[bj][n][3] * v[bj][n][3]); }
                    if (kind) { ss += __shfl_xor(ss, 16); ss += __shfl_xor(ss, 32); const float rn = rsqrtf(ss * (1.0f / 64.0f) + 1e-6f) * post;
#pragma unroll
                        for (int bj = 0; bj < 2; ++bj)
#pragma unroll
                            for (int n = 0; n < 2; ++n) v[bj][n] = v[bj][n] * rn * wg[bj][n]; }
#pragma unroll
                    for (int bj = 0; bj < 2; ++bj) { const int col = gbase + 32 * bj + 8 * fq;
                        if (col < ncols) {
                            if (NRM == 1 && col >= 4096) { float* dp = dtb + (size_t)row * 16 + (col - 4096); *(f32x4*)dp = v[bj][0]; *(f32x4*)(dp + 4) = v[bj][1]; }
                            u32x4 w; w.x = cvt_pk_bf16(v[bj][0][0], v[bj][0][1]); w.y = cvt_pk_bf16(v[bj][0][2], v[bj][0][3]); w.z = cvt_pk_bf16(v[bj][1][0], v[bj][1][1]); w.w = cvt_pk_bf16(v[bj][1][2], v[bj][1][3]);
                            *(u32x4*)(rowp + col) = w; } } }
        }
    }
};
template <bool RESF, bool OUTF, bool SCALE = false> struct EpiRes {
    static constexpr bool PERM = true, AFTER_DRAIN = false;
    const float* resf; bf16_t* xb; float* outf; float* ssq; const float* ssq_in;
    __device__ __forceinline__ void operator()(const f32x4 (&acc)[2][2][4][2], const Unit& u, int wr, int wc, int fr, int fq) const {
        const int row0 = u.pm * BM + wr * 64 + fr; const int col0 = u.pn * BM + wc * 32 + 8 * fq;
        constexpr int CH = RESF ? 2 : 4;
#pragma unroll
        for (int ai = 0; ai < 2; ++ai)
#pragma unroll
            for (int m0 = 0; m0 < 4; m0 += CH) {
                f32x4 rf[CH][2][2]; u32x4 rb[CH][2]; float sqi[CH];
#pragma unroll
                for (int mm = 0; mm < CH; ++mm) sqi[mm] = SCALE ? ssq_in[row0 + ai * HALF + (m0 + mm) * 16] : 0.f;
#pragma unroll
                for (int mm = 0; mm < CH; ++mm)
#pragma unroll
                    for (int bj = 0; bj < 2; ++bj) { const size_t off = (size_t)(row0 + ai * HALF + (m0 + mm) * 16) * 1024 + col0 + bj * HALF;
                        if (RESF) { rf[mm][bj][0] = *(const f32x4*)(resf + off); rf[mm][bj][1] = *(const f32x4*)(resf + off + 4); } else rb[mm][bj] = *(const u32x4*)(xb + off); }
#pragma unroll
                for (int mm = 0; mm < CH; ++mm) { const int m = m0 + mm; const int row = row0 + ai * HALF + m * 16; float s = 0.f;
#pragma unroll
                    for (int bj = 0; bj < 2; ++bj) { const size_t off = (size_t)row * 1024 + col0 + bj * HALF;
                        f32x4 r0, r1;
                        if (RESF) { r0 = rf[mm][bj][0]; r1 = rf[mm][bj][1]; }
                        else { const u32x4 rw = rb[mm][bj];
                            r0 = (f32x4){__uint_as_float(rw.x << 16), __uint_as_float(rw.x & 0xffff0000u), __uint_as_float(rw.y << 16), __uint_as_float(rw.y & 0xffff0000u)};
                            r1 = (f32x4){__uint_as_float(rw.z << 16), __uint_as_float(rw.z & 0xffff0000u), __uint_as_float(rw.w << 16), __uint_as_float(rw.w & 0xffff0000u)}; }
                        const float sc2 = SCALE ? 1.0f / (sqi[mm] * (1.0f / 1024.0f) + 1e-6f) : 1.0f;
                        const f32x4 o0 = r0 + acc[ai][bj][m][0] * sc2, o1 = r1 + acc[ai][bj][m][1] * sc2;
                        if (OUTF) { *(f32x4*)(outf + off) = o0; *(f32x4*)(outf + off + 4) = o1; }
                        else { u32x4 w; w.x = cvt_pk_bf16(o0[0], o0[1]); w.y = cvt_pk_bf16(o0[2], o0[3]); w.z = cvt_pk_bf16(o1[0], o1[1]); w.w = cvt_pk_bf16(o1[2], o1[3]); *(u32x4*)(xb + off) = w;
                            s += (o0[0] * o0[0] + o0[1] * o0[1]) + (o0[2] * o0[2] + o0[3] * o0[3]) + (o1[0] * o1[0] + o1[1] * o1[1]) + (o1[2] * o1[2] + o1[3] * o1[3]); } }
                    if (!OUTF) { s += __shfl_xor(s, 16); s += __shfl_xor(s, 32); if (fq == 0) atomicAdd(ssq + row, s); } }
            }
    }
};
template <class Epi, class Sched, bool ALIGN_EPI = false, bool SP2 = false>
__device__ __forceinline__ void gemm_phase(PG8_LAS unsigned char* lds, const Gemm g, const Sched& S, const Epi& E) {
    const int tid = threadIdx.x, wid = __builtin_amdgcn_readfirstlane(tid >> 6), lane = tid & 63, wr = wid >> 2, wc = wid & 3, fr = lane & 15, fq = lane >> 4;
    const int K = g.K, nt = K / BK;
    unsigned voffA[2], voffB[2];
#pragma unroll
    for (int i = 0; i < 2; ++i) { int R, C; stage_rc(tid * 16 + i * 8192, R, C); const int Rb = Epi::PERM ? ((R & ~31) + perm32(R & 31)) : R;
        voffA[i] = (unsigned)(R * K + C) * 2u; voffB[i] = (unsigned)(Rb * K + C) * 2u; }
    const size_t kstep = (size_t)(BK * 2);
    const size_t hstep = (size_t)HALF * K * 2;
    const size_t tstep = 2 * hstep;
    const unsigned ldsw = (unsigned)wid * 1024u;
    const int aoff = lds_byte(wr * 64 + fr, fq * 8), boff = lds_byte(wc * 32 + fr, fq * 8);
#define PG8_SA(b, h) (((b) * 2 + (h)) * HTB)
#define PG8_SB(b, h) ((4 + (b) * 2 + (h)) * HTB)
#define PG8_STAGE(bufoff, gbase, voff) do { _Pragma("unroll") for (int _i = 0; _i < 2; ++_i) \
        __builtin_amdgcn_global_load_lds((const unsigned*)((const char*)(gbase) + (voff)[_i]), (PG8_LAS unsigned*)(lds + (bufoff) + ldsw + _i * 8192), 16, 0, 0); } while (0)
#define PG8_LDA(dst, b, h) do { _Pragma("unroll") for (int m = 0; m < 4; ++m) _Pragma("unroll") for (int k = 0; k < 2; ++k) dst[m][k] = *(const PG8_LAS bf16x8*)(lds + PG8_SA(b, h) + aoff + m * 2048 + k * 1024); } while (0)
#define PG8_LDB(dst, b, h) do { _Pragma("unroll") for (int n = 0; n < 2; ++n) _Pragma("unroll") for (int k = 0; k < 2; ++k) dst[n][k] = *(const PG8_LAS bf16x8*)(lds + PG8_SB(b, h) + boff + n * 2048 + k * 1024); } while (0)
#define PG8_MMA(ai, bj, At, Bt) do { __builtin_amdgcn_s_setprio(1); _Pragma("unroll") for (int m = 0; m < 4; ++m) _Pragma("unroll") for (int n = 0; n < 2; ++n) _Pragma("unroll") for (int k = 0; k < 2; ++k) \
        acc[ai][bj][m][n] = __builtin_amdgcn_mfma_f32_16x16x32_bf16(Bt[n][k], At[m][k], acc[ai][bj][m][n], 0, 0, 0); __builtin_amdgcn_s_setprio(0); } while (0)
#define PG8_WAIT_V(n) asm volatile("s_waitcnt vmcnt(" #n ")" ::: "memory")
#define PG8_WAIT_L(n) asm volatile("s_waitcnt lgkmcnt(" #n ")" ::: "memory")
#define PG8_BAR __builtin_amdgcn_s_barrier()
#define PG8_SCHED __builtin_amdgcn_sched_barrier(0)
    Unit cur, nxt; int ui = 0;
    if (!S.next(0, cur)) return;
    f32x4 acc[2][2][4][2];
#pragma unroll
    for (int a = 0; a < 2; ++a)
#pragma unroll
        for (int b = 0; b < 2; ++b)
#pragma unroll
            for (int m = 0; m < 4; ++m)
#pragma unroll
                for (int n = 0; n < 2; ++n) acc[a][b][m][n] = (f32x4){0.f, 0.f, 0.f, 0.f};
    bf16x8 At[4][2], B0[2][2], B1[2][2];
    const char* cA = (const char*)g.A + (size_t)cur.pm * tstep; const char* cB = (const char*)g.Bt + (size_t)cur.pn * tstep;
    S.a_ready(cur);
    if constexpr (SP2) {
        PG8_STAGE(PG8_SB(0, 0), cB, voffB); PG8_STAGE(PG8_SB(0, 1), cB + hstep, voffB); PG8_STAGE(PG8_SA(0, 0), cA, voffA); PG8_STAGE(PG8_SA(0, 1), cA + hstep, voffA);
        if (wr == 1) PG8_BAR;
        PG8_WAIT_V(2); PG8_BAR;
        PG8_STAGE(PG8_SB(1, 0), cB + kstep, voffB); PG8_STAGE(PG8_SA(1, 0), cA + kstep, voffA); PG8_STAGE(PG8_SB(1, 1), cB + hstep + kstep, voffB);
        PG8_WAIT_V(6); PG8_BAR;
    } else {
        PG8_STAGE(PG8_SB(0, 0), cB, voffB); PG8_STAGE(PG8_SA(0, 0), cA, voffA); PG8_STAGE(PG8_SB(0, 1), cB + hstep, voffB); PG8_STAGE(PG8_SA(0, 1), cA + hstep, voffA);
        if (wr == 1) PG8_BAR;
        PG8_WAIT_V(4); PG8_BAR;
        PG8_STAGE(PG8_SB(1, 0), cB + kstep, voffB); PG8_STAGE(PG8_SA(1, 0), cA + kstep, voffA); PG8_STAGE(PG8_SB(1, 1), cB + hstep + kstep, voffB);
        PG8_WAIT_V(6); PG8_BAR;
    }
    for (;;) {
        const bool has_next = S.next(ui + 1, nxt);
        const char* nA = has_next ? (const char*)g.A + (size_t)nxt.pm * tstep : cA; const char* nB = has_next ? (const char*)g.Bt + (size_t)nxt.pn * tstep : cB;
        for (int t = 0; t < nt; t += 2) {
            const bool last = (t == nt - 2);
            const char* a1 = cA + (size_t)(t + 1) * kstep;
            const char* a2 = last ? nA : cA + (size_t)(t + 2) * kstep; const char* b2 = last ? nB : cB + (size_t)(t + 2) * kstep;
            const char* a3 = a2 + kstep; const char* b3 = b2 + kstep;
            if (last && has_next) S.a_ready(nxt);
            if constexpr (SP2) {
            PG8_LDB(B0, 0, 0); PG8_LDB(B1, 0, 1); PG8_SCHED; PG8_LDA(At, 0, 0); PG8_STAGE(PG8_SA(1, 1), a1 + hstep, voffA);
            PG8_WAIT_V(8); PG8_WAIT_L(0); PG8_BAR; PG8_MMA(0, 0, At, B0); PG8_MMA(0, 1, At, B1); PG8_BAR; PG8_SCHED;
            PG8_LDA(At, 0, 1); PG8_STAGE(PG8_SB(0, 0), b2, voffB); PG8_STAGE(PG8_SB(0, 1), b2 + hstep, voffB); PG8_STAGE(PG8_SA(0, 0), a2, voffA);
            PG8_WAIT_V(8); PG8_WAIT_L(0); PG8_BAR; PG8_MMA(1, 0, At, B0); PG8_MMA(1, 1, At, B1); PG8_BAR; PG8_SCHED;
            PG8_LDB(B0, 1, 0); PG8_LDB(B1, 1, 1); PG8_SCHED; PG8_LDA(At, 1, 0); PG8_STAGE(PG8_SA(0, 1), a2 + hstep, voffA);
            PG8_WAIT_V(8); PG8_WAIT_L(0); PG8_BAR; PG8_MMA(0, 0, At, B0); PG8_MMA(0, 1, At, B1); PG8_BAR; PG8_SCHED;
            PG8_LDA(At, 1, 1); PG8_STAGE(PG8_SB(1, 0), b3, voffB); PG8_STAGE(PG8_SB(1, 1), b3 + hstep, voffB); PG8_STAGE(PG8_SA(1, 0), a3, voffA);
            PG8_WAIT_V(8); PG8_WAIT_L(0); PG8_BAR; PG8_MMA(1, 0, At, B0); PG8_MMA(1, 1, At, B1); PG8_BAR; PG8_SCHED;
            } else {
            PG8_LDB(B0, 0, 0); PG8_SCHED; PG8_LDA(At, 0, 0); PG8_STAGE(PG8_SA(1, 1), a1 + hstep, voffA);
            PG8_WAIT_L(8); PG8_BAR; PG8_WAIT_L(0); PG8_MMA(0, 0, At, B0); PG8_BAR; PG8_SCHED;
            PG8_LDB(B1, 0, 1); PG8_STAGE(PG8_SB(0, 0), b2, voffB);
            PG8_BAR; PG8_WAIT_L(0); PG8_MMA(0, 1, At, B1); PG8_BAR;
            PG8_LDA(At, 0, 1); PG8_STAGE(PG8_SA(0, 0), a2, voffA);
            PG8_BAR; PG8_WAIT_L(0); PG8_MMA(1, 0, At, B0); PG8_BAR; PG8_SCHED;
            PG8_STAGE(PG8_SB(0, 1), b2 + hstep, voffB);
            PG8_WAIT_V(6); PG8_BAR; PG8_MMA(1, 1, At, B1); PG8_BAR;
            PG8_LDB(B0, 1, 0); PG8_SCHED; PG8_LDA(At, 1, 0); PG8_STAGE(PG8_SA(0, 1), a2 + hstep, voffA);
            PG8_WAIT_L(8); PG8_BAR; PG8_WAIT_L(0); PG8_MMA(0, 0, At, B0); PG8_BAR; PG8_SCHED;
            PG8_LDB(B1, 1, 1); PG8_STAGE(PG8_SB(1, 0), b3, voffB);
            PG8_BAR; PG8_WAIT_L(0); PG8_MMA(0, 1, At, B1); PG8_BAR;
            PG8_LDA(At, 1, 1); PG8_STAGE(PG8_SA(1, 0), a3, voffA);
            PG8_BAR; PG8_WAIT_L(0); PG8_MMA(1, 0, At, B0); PG8_BAR; PG8_SCHED;
            PG8_STAGE(PG8_SB(1, 1), b3 + hstep, voffB);
            PG8_WAIT_V(6); PG8_BAR; PG8_MMA(1, 1, At, B1); PG8_BAR;
            }
        }
        if constexpr (ALIGN_EPI) { if (wr == 0) PG8_BAR; }
        if constexpr (!Epi::AFTER_DRAIN) { E(acc, cur, wr, wc, fr, fq); S.done(cur); }
        if (!has_next) break;
#pragma unroll
        for (int a = 0; a < 2; ++a)
#pragma unroll
            for (int b = 0; b < 2; ++b)
#pragma unroll
                for (int m = 0; m < 4; ++m)
#pragma unroll
                    for (int n = 0; n < 2; ++n) acc[a][b][m][n] = (f32x4){0.f, 0.f, 0.f, 0.f};
        cur = nxt; cA = nA; cB = nB; ++ui;
        if constexpr (ALIGN_EPI) { if (wr == 1) PG8_BAR; }
    }
    PG8_WAIT_V(0);
    if constexpr (!ALIGN_EPI) { if (wr == 0) PG8_BAR; }
    PG8_BAR;
    if constexpr (Epi::AFTER_DRAIN) { E.fused(acc, cur, wr, wc, fr, fq, lds, wid, lane); S.done(cur); }
#undef PG8_SA
#undef PG8_SB
#undef PG8_STAGE
#undef PG8_LDA
#undef PG8_LDB
#undef PG8_MMA
#undef PG8_WAIT_V
#undef PG8_WAIT_L
#undef PG8_BAR
#undef PG8_SCHED
}
}
#ifndef ONE_LAUNCH
#define ONE_LAUNCH 1
#endif
#define LAS __attribute__((address_space(3)))
typedef unsigned short bf16_t;
typedef short bf16x8 __attribute__((ext_vector_type(8)));
typedef short s16x4 __attribute__((ext_vector_type(4)));
typedef float f32x4 __attribute__((ext_vector_type(4)));
typedef unsigned u32x4 __attribute__((ext_vector_type(4)));
typedef unsigned u32x2 __attribute__((ext_vector_type(2)));

constexpr int BATCH = 8, T = 4096, D = 1024, M = BATCH * T, FF = 4096;
constexpr int NPROJ = 4112, NPROJ_PAD = 4352, NQKV = 3072, NMIX = 2048;
constexpr int C_Z = 0, C_XBC = 1024, C_Q = 2560, C_K = 3584, C_V = 3840;
constexpr float EPS = 1e-6f;
constexpr float LOG2E = 1.4426950408889634f;
constexpr size_t MiB = 1u << 20;
constexpr size_t WS_SSQ = 0;
constexpr size_t WS_CD = 512 * 1024;
constexpr size_t WS_DT = 1 * MiB;
constexpr size_t WS_WIN = 3 * MiB, WS_WOE = 12 * MiB, WS_W1 = 16 * MiB  , WS_W2 = 32 * MiB  , WS_WQKV = 48 * MiB, WS_WOO = 54 * MiB;
constexpr size_t WS_XB = 56 * MiB;
constexpr size_t WS_PROJ = 120 * MiB;
constexpr size_t WS_Y = 377 * MiB;
constexpr size_t WS_END = 505 * MiB;
constexpr int LDS_BYTES = 147456;
constexpr int NPHASE = 13;

struct Params { const float* in[26]; float* out; unsigned char* ws; int ph_lo, ph_hi; };

__device__ __forceinline__ float bflo(unsigned u) { return __uint_as_float(u << 16); }
__device__ __forceinline__ float bfhi(unsigned u) { return __uint_as_float(u & 0xffff0000u); }
__device__ __forceinline__ float bf1(bf16_t v) { return __uint_as_float(((unsigned)v) << 16); }
typedef float f32x2_t __attribute__((ext_vector_type(2)));
typedef __bf16 bf16x2_t __attribute__((ext_vector_type(2)));
__device__ __forceinline__ unsigned pk2(float lo, float hi) { f32x2_t v = {lo, hi}; bf16x2_t b = __builtin_convertvector(v, bf16x2_t); return __builtin_bit_cast(unsigned, b); }
__device__ __forceinline__ void unpack8(const u32x4 r, float (&v)[8]) { v[0] = bflo(r.x); v[1] = bfhi(r.x); v[2] = bflo(r.y); v[3] = bfhi(r.y); v[4] = bflo(r.z); v[5] = bfhi(r.z); v[6] = bflo(r.w); v[7] = bfhi(r.w); }
__device__ __forceinline__ u32x4 pack8(const float (&v)[8]) { u32x4 r; r.x = pk2(v[0], v[1]); r.y = pk2(v[2], v[3]); r.z = pk2(v[4], v[5]); r.w = pk2(v[6], v[7]); return r; }
__device__ __forceinline__ f32x4 mfma16(bf16x8 a, bf16x8 b, f32x4 c) { return __builtin_amdgcn_mfma_f32_16x16x32_bf16(a, b, c, 0, 0, 0); }
__device__ __forceinline__ bf16x8 as_frag(u32x4 r) { return __builtin_bit_cast(bf16x8, r); }
__device__ __forceinline__ float siluf(float v) { return v * __builtin_amdgcn_rcpf(1.0f + __builtin_amdgcn_exp2f(-1.4426950408889634f * v)); }
typedef short v4i16_t __attribute__((ext_vector_type(4)));
__device__ __forceinline__ u32x2 lds_tr(const LAS bf16_t* p) { return __builtin_bit_cast(u32x2, __builtin_amdgcn_ds_read_tr16_b64_v4i16((LAS v4i16_t*)p)); }

__device__ __forceinline__ int map_cols(int mode, int n0, int& nvalid) {
    if (mode == 0) { nvalid = 32; return n0; }
    const int tile = n0 >> 8, within = n0 & 255, bj = within >> 7, wc = (within & 127) >> 5;
    const int cl = tile * 256 + 64 * wc + 32 * bj;
    if (mode == 2) { nvalid = 32; return cl; }
    if (cl < 2560) { nvalid = 32; return cl; }
    if (cl < 4096) { nvalid = 32; return cl + 16; }
    if (cl == 4096) { nvalid = 16; return 2560; }
    nvalid = 0; return 0;
}
__device__ __forceinline__ void p0_transpose_item(const float* W, int K, int Nsrc, int Nphys, int mode, bf16_t* WT, const float* ksc, LAS float* scr, int item, int lane) {
    const int nblk = Nphys / 32, kb = item / nblk, nb = item % nblk, k0 = 64 * kb, n0 = 32 * nb;
    int nvalid; const int ns0 = map_cols(mode, n0, nvalid);
    const int kk8 = lane >> 3, n4 = (lane & 7) * 4;
    const bool ok = n4 < nvalid;
    float kscv[8]; f32x4 wv[8];
#pragma unroll
    for (int i = 0; i < 8; ++i) kscv[i] = ksc ? ksc[k0 + 8 * i + kk8] : 1.0f;
#pragma unroll
    for (int i = 0; i < 8; ++i) { const int kk = 8 * i + kk8; wv[i] = ok ? *(const f32x4*)(W + (size_t)(k0 + kk) * Nsrc + ns0 + n4) : (f32x4){0.f, 0.f, 0.f, 0.f}; }
#pragma unroll
    for (int i = 0; i < 8; ++i) { const int kk = 8 * i + kk8; const f32x4 v = wv[i] * kscv[i];
        LAS float* d = scr + kk * 33 + n4; d[0] = v[0]; d[1] = v[1]; d[2] = v[2]; d[3] = v[3]; }
    asm volatile("s_waitcnt lgkmcnt(0)" ::: "memory");
    const int c = lane & 7;
#pragma unroll
    for (int j = 0; j < 4; ++j) { const int n = (lane >> 3) + 8 * j; const LAS float* sp = scr + (8 * c) * 33 + n;
        u32x4 o; o.x = pk2(sp[0 * 33], sp[1 * 33]); o.y = pk2(sp[2 * 33], sp[3 * 33]); o.z = pk2(sp[4 * 33], sp[5 * 33]); o.w = pk2(sp[6 * 33], sp[7 * 33]);
        *(u32x4*)(WT + (size_t)(n0 + n) * K + k0 + 8 * c) = o; }
    asm volatile("s_waitcnt lgkmcnt(0)" ::: "memory");
}
__device__ __forceinline__ void p0_prologue(const Params& P, LAS unsigned char* lds, int G) {
    const int tid = threadIdx.x, lane = tid & 63, wave = tid >> 6;
    LAS float* scr = (LAS float*)(lds + wave * 16384);
    const int gw = blockIdx.x * 8 + wave, NGW = G * 8;
    unsigned char* ws = P.ws;
    constexpr int I0 = 16 * 128, I1 = 32 * 32, I2 = 16 * 128, I3 = I2, I4 = 64 * 32, I5 = I4, I6 = 16 * 96, I7 = 16 * 32;
    constexpr int NIT = I0 + I1 + I2 + I3 + I4 + I5 + I6 + I7;
    for (int it = gw; it < NIT; it += NGW) {
        int r = it;
        if (r < I0) { p0_transpose_item(P.in[2], D, NPROJ, 4096, 1, (bf16_t*)(ws + WS_WIN), P.in[1], scr, r, lane)    ; continue; } r -= I0;
        if (r < I1) { p0_transpose_item(P.in[12], NMIX, D, D, 0, (bf16_t*)(ws + WS_WOE), nullptr, scr, r, lane); continue; } r -= I1;
        if (r < I2) { p0_transpose_item(P.in[24], D, FF, FF, 0, (bf16_t*)(ws + WS_W1), P.in[23], scr, r, lane); continue; } r -= I2;
        if (r < I3) { p0_transpose_item(P.in[24] + (size_t)D * FF, D, FF, FF, 0, (bf16_t*)(ws + WS_W1 + 8 * MiB), P.in[23] + D, scr, r, lane); continue; } r -= I3;
        if (r < I4) { p0_transpose_item(P.in[25], FF, D, D, 0, (bf16_t*)(ws + WS_W2), nullptr, scr, r, lane); continue; } r -= I4;
        if (r < I5) { p0_transpose_item(P.in[25] + (size_t)D * FF, FF, D, D, 0, (bf16_t*)(ws + WS_W2 + 8 * MiB), nullptr, scr, r, lane); continue; } r -= I5;
        if (r < I6) { p0_transpose_item(P.in[14], D, NQKV, NQKV, 2, (bf16_t*)(ws + WS_WQKV), P.in[13], scr, r, lane); continue; } r -= I6;
        p0_transpose_item(P.in[22], D, D, D, 0, (bf16_t*)(ws + WS_WOO), nullptr, scr, r, lane);
    }
    { float* z = (float*)(ws + WS_SSQ) + M; for (int i = blockIdx.x * 512 + tid; i < 3 * M; i += G * 512) z[i] = 0.f; }
    const float* x = P.in[0]; bf16_t* XB = (bf16_t*)(ws + WS_XB); float* ssq0 = (float*)(ws + WS_SSQ); float* dtb = (float*)(ws + WS_DT);
    constexpr int WDP = 1032;
    LAS bf16_t* Wd = (LAS bf16_t*)lds;
    __syncthreads();
    { const float* Wsrc = P.in[2]; const float* nw = P.in[1];
#pragma unroll
      for (int q = 0; q < 2; ++q) { const int k = 2 * tid + q; const float sc = nw[k]; const f32x4* wr = (const f32x4*)(Wsrc + (size_t)k * NPROJ + 2560);
          const f32x4 w0 = wr[0] * sc, w1 = wr[1] * sc, w2 = wr[2] * sc, w3 = wr[3] * sc;
          const float wv[16] = {w0[0], w0[1], w0[2], w0[3], w1[0], w1[1], w1[2], w1[3], w2[0], w2[1], w2[2], w2[3], w3[0], w3[1], w3[2], w3[3]};
#pragma unroll
          for (int h = 0; h < 16; ++h) Wd[h * WDP + k] = (bf16_t)(pk2(wv[h], wv[h]) & 0xffffu); } }
    __syncthreads();
    { const int g = lane >> 4, i = lane & 15;
      for (int grp = gw; grp < M / 16; grp += NGW) {
        const int row = 16 * grp + i; const float* xr = x + (size_t)row * D + 8 * g; bf16_t* xo = XB + (size_t)row * D + 8 * g;
        f32x4 cacc = (f32x4){0.f, 0.f, 0.f, 0.f}; float ss = 0.f;
        f32x4 xa[2][4], xb2[2][4];
#pragma unroll
        for (int q = 0; q < 4; ++q) { xa[0][q] = *(const f32x4*)(xr + 32 * q); xb2[0][q] = *(const f32x4*)(xr + 32 * q + 4); }
#pragma unroll
        for (int kb = 0; kb < 8; ++kb) {
            if (kb < 7) {
#pragma unroll
                for (int q = 0; q < 4; ++q) { xa[(kb + 1) & 1][q] = *(const f32x4*)(xr + 32 * (4 * (kb + 1) + q)); xb2[(kb + 1) & 1][q] = *(const f32x4*)(xr + 32 * (4 * (kb + 1) + q) + 4); }
            }
#pragma unroll
            for (int q = 0; q < 4; ++q) { const int ks = 4 * kb + q; const f32x4 a = xa[kb & 1][q], c = xb2[kb & 1][q];
                ss += (a[0] * a[0] + a[1] * a[1]) + (a[2] * a[2] + a[3] * a[3]) + (c[0] * c[0] + c[1] * c[1]) + (c[2] * c[2] + c[3] * c[3]);
                u32x4 pk; pk.x = pk2(a[0], a[1]); pk.y = pk2(a[2], a[3]); pk.z = pk2(c[0], c[1]); pk.w = pk2(c[2], c[3]);
                *(u32x4*)(xo + 32 * ks) = pk;
                const bf16x8 wf = *(const LAS bf16x8*)(Wd + i * WDP + 32 * ks + 8 * g);
                cacc = mfma16(as_frag(pk), wf, cacc); }
        }
        ss += __shfl_xor(ss, 16); ss += __shfl_xor(ss, 32);
        if (g == 0) ssq0[row] = ss;
#pragma unroll
        for (int r = 0; r < 4; ++r) { const float sr = __shfl(ss, 4 * g + r); dtb[(size_t)(16 * grp + 4 * g + r) * 16 + i] = cacc[r] * rsqrtf(sr * (1.0f / 1024.0f) + EPS); }
      } }
}

template <int NQK, int NK, int DV>
__device__ __forceinline__ void attn_tile(const LAS unsigned char* buf, const bf16x8 (&qf)[NQK][2], f32x4 (&acc)[NQK][DV / 16], float (&lrun)[NQK],
                                          const float (&slope2v)[NQK], int qrel, int j, bool diag, int g, int i) {
    constexpr int KP = 72, VP = DV + 16, NDT = DV / 16, KBYTES = NK * 64 * KP * 2;
    const LAS bf16_t* Ks = (const LAS bf16_t*)buf; const LAS bf16_t* Vn = (const LAS bf16_t*)(buf + KBYTES);
    constexpr int HG = NQK < 2 ? NQK : 2;
#pragma unroll
    for (int a0 = 0; a0 < NQK; a0 += HG) {
    bf16x8 pf[HG][2];
#pragma unroll
    for (int aa = 0; aa < HG; ++aa) {
        const int a = a0 + aa;
        f32x4 s[4]; const float slope2 = slope2v[a]; const int ka = (NK == NQK) ? a : 0;
        float oz = 0.f; asm volatile("" : "+v"(oz));
        f32x4 binit[4];
        if (!diag) {
            float bb = slope2 * (float)(64 * j - qrel + 4 * g) + oz; const float s12 = 12.0f * slope2;
#pragma unroll
            for (int kt = 0; kt < 4; ++kt) {
#pragma unroll
                for (int r = 0; r < 4; ++r) { binit[kt][r] = bb; bb += slope2; }
                bb += s12; }
        } else {
            float dd = (float)(qrel - 64 * j - 4 * g) + oz;
#pragma unroll
            for (int kt = 0; kt < 4; ++kt) {
#pragma unroll
                for (int r = 0; r < 4; ++r) { binit[kt][r] = -slope2 * fabsf(dd); dd -= 1.0f; }
                dd -= 12.0f; }
        }
#pragma unroll
        for (int kt = 0; kt < 4; ++kt) { f32x4 c = binit[kt];
#pragma unroll
            for (int ks = 0; ks < 2; ++ks) { const bf16x8 kf = *(const LAS bf16x8*)(Ks + (ka * 64 + 16 * kt + i) * KP + 32 * ks + 8 * g); c = mfma16(kf, qf[a][ks], c); }
            s[kt] = c; }
        float ls = 0.f;
#pragma unroll
        for (int kt = 0; kt < 4; ++kt)
#pragma unroll
            for (int r = 0; r < 4; ++r) { s[kt][r] = __builtin_amdgcn_exp2f(s[kt][r]); ls += s[kt][r]; }
        lrun[a] += ls;
#pragma unroll
        for (int s2 = 0; s2 < 2; ++s2) { u32x4 p; p.x = pk2(s[2 * s2][0], s[2 * s2][1]); p.y = pk2(s[2 * s2][2], s[2 * s2][3]); p.z = pk2(s[2 * s2 + 1][0], s[2 * s2 + 1][1]); p.w = pk2(s[2 * s2 + 1][2], s[2 * s2 + 1][3]); pf[aa][s2] = as_frag(p); }
    }
#pragma unroll
    for (int dt = 0; dt < NDT; ++dt)
#pragma unroll
        for (int s2 = 0; s2 < 2; ++s2) {
            const LAS bf16_t* vp = Vn + (32 * s2 + 4 * g + (i >> 2)) * VP + 16 * dt + 4 * (i & 3);
            const u32x2 lo = lds_tr(vp), hi = lds_tr(vp + 16 * VP);
            u32x4 vv; vv.x = lo.x; vv.y = lo.y; vv.z = hi.x; vv.w = hi.y; const bf16x8 vf = as_frag(vv);
#pragma unroll
            for (int aa = 0; aa < HG; ++aa) acc[a0 + aa][dt] = mfma16(vf, pf[aa][s2], acc[a0 + aa][dt]);
        }
    }
}
template <int NQK, int NK, int DV>
__device__ __forceinline__ void attn_unit(LAS unsigned char* lds, const bf16_t* Qg, const bf16_t* Kg, const bf16_t* Vg, int pitch,
                                          int q0, int jlo, int jhi, int wlo, int whi, const float (&slope2v)[NQK], const float (&linit)[NQK],
                                          bf16_t* Og, int opitch, float lam, const float* subw, float oscale) {
    constexpr int KP = 72, VP = DV + 16, NDT = DV / 16, NVP = DV / 64;
    constexpr int KBYTES = NK * 64 * KP * 2, BUFBYTES = KBYTES + 64 * VP * 2;
    const int tid = threadIdx.x, lane = tid & 63, w = __builtin_amdgcn_readfirstlane(tid >> 6), g = lane >> 4, i = lane & 15;
    bf16x8 qf[NQK][2];
    {
        const bf16_t* qrow = Qg + (size_t)(16 * w + i) * pitch;
#pragma unroll
        for (int a = 0; a < NQK; ++a) { u32x4 r0 = *(const u32x4*)(qrow + a * 64 + 8 * g), r1 = *(const u32x4*)(qrow + a * 64 + 32 + 8 * g);
            asm volatile("" : "+v"(r0), "+v"(r1));
            qf[a][0] = as_frag(r0); qf[a][1] = as_frag(r1); }
    }
    const int krow = tid >> 3, kseg = tid & 7;
    u32x4 kA[NK], vA[NVP], kB[NK], vB[NVP];
    f32x4 acc[NQK][NDT];
    float lrun[NQK];
#pragma unroll
    for (int a = 0; a < NQK; ++a) { lrun[a] = (g == 0) ? linit[a] : 0.f;
#pragma unroll
        for (int dt = 0; dt < NDT; ++dt) acc[a][dt] = (f32x4){0.f, 0.f, 0.f, 0.f}; }
    const int qrel = q0 + 16 * w + i;
#define ATT_PREFETCH(KR, VR, jj) do { _Pragma("unroll") for (int a = 0; a < NK; ++a) KR[a] = *(const u32x4*)(Kg + (size_t)((jj) * 64 + krow) * pitch + a * 64 + 8 * kseg); \
        _Pragma("unroll") for (int pc = 0; pc < NVP; ++pc) { const int idx = tid + 512 * pc, key = idx / (DV / 8), seg = idx % (DV / 8); VR[pc] = *(const u32x4*)(Vg + (size_t)((jj) * 64 + key) * pitch + 8 * seg); } } while (0)
#define ATT_STAGE(KR, VR, bb) do { LAS bf16_t* Ks_ = (LAS bf16_t*)(lds + (bb) * BUFBYTES); LAS bf16_t* Vn_ = (LAS bf16_t*)(lds + (bb) * BUFBYTES + KBYTES); \
        _Pragma("unroll") for (int a = 0; a < NK; ++a) *(LAS u32x4*)(Ks_ + (a * 64 + krow) * KP + 8 * kseg) = KR[a]; \
        _Pragma("unroll") for (int pc = 0; pc < NVP; ++pc) { const int idx = tid + 512 * pc, key = idx / (DV / 8), seg = idx % (DV / 8); *(LAS u32x4*)(Vn_ + key * VP + 8 * seg) = VR[pc]; } } while (0)
    ATT_PREFETCH(kA, vA, jlo);
    ATT_STAGE(kA, vA, 0);
    if (jlo + 1 <= jhi) ATT_PREFETCH(kA, vA, jlo + 1);
    if (jlo + 2 <= jhi) ATT_PREFETCH(kB, vB, jlo + 2);
    for (int j = jlo; j <= jhi; j += 2) {
        __syncthreads();
        if (j + 1 <= jhi) { ATT_STAGE(kA, vA, 1); if (j + 3 <= jhi) ATT_PREFETCH(kA, vA, j + 3); }
        if (j >= wlo && j <= whi) attn_tile<NQK, NK, DV>(lds, qf, acc, lrun, slope2v, qrel, j, j == whi, g, i);
        if (j + 1 <= jhi) {
            __syncthreads();
            if (j + 2 <= jhi) { ATT_STAGE(kB, vB, 0); if (j + 4 <= jhi) ATT_PREFETCH(kB, vB, j + 4); }
            if (j + 1 >= wlo && j + 1 <= whi) attn_tile<NQK, NK, DV>(lds + BUFBYTES, qf, acc, lrun, slope2v, qrel, j + 1, j + 1 == whi, g, i);
        }
    }
#undef ATT_PREFETCH
#undef ATT_STAGE
#pragma unroll
    for (int a = 0; a < NQK; ++a) { lrun[a] += __shfl_xor(lrun[a], 16); lrun[a] += __shfl_xor(lrun[a], 32); }
    bf16_t* orow = Og + (size_t)(16 * w + i) * opitch;
    if constexpr (NK == 2) {
        const float i0 = 1.0f / lrun[0], i1 = lam / lrun[1];
        f32x4 o[NDT]; float ss = 0.f;
#pragma unroll
        for (int dt = 0; dt < NDT; ++dt) { o[dt] = acc[0][dt] * i0 - acc[1][dt] * i1; ss += (o[dt][0] * o[dt][0] + o[dt][1] * o[dt][1]) + (o[dt][2] * o[dt][2] + o[dt][3] * o[dt][3]); }
        ss += __shfl_xor(ss, 16); ss += __shfl_xor(ss, 32);
        const float rs = rsqrtf(ss * (1.0f / (float)DV) + EPS) * oscale;
        f32x4 swv[NDT];
#pragma unroll
        for (int dt = 0; dt < NDT; ++dt) swv[dt] = *(const f32x4*)(subw + 16 * dt + 4 * g);
#pragma unroll
        for (int dt = 0; dt < NDT; ++dt) { const f32x4 sw = swv[dt]; const f32x4 v = o[dt] * rs * sw;
            u32x2 pkd; pkd.x = pk2(v[0], v[1]); pkd.y = pk2(v[2], v[3]); *(u32x2*)(orow + 16 * dt + 4 * g) = pkd; }
    } else {
#pragma unroll
        for (int a = 0; a < NQK; ++a) { const float i0 = 1.0f / lrun[a];
#pragma unroll
            for (int dt = 0; dt < NDT; ++dt) { const f32x4 v = acc[a][dt] * i0; u32x2 pkd; pkd.x = pk2(v[0], v[1]); pkd.y = pk2(v[2], v[3]); *(u32x2*)(orow + a * DV + 16 * dt + 4 * g) = pkd; } }
    }
}
template <bool TRANS>
__device__ __forceinline__ void conv_item(const bf16_t* xbc, int tg0, int c0, const float* cw, const float* cb, u32x4 (&out)[8]) {
    float wgt[4][8], bias[8];
#pragma unroll
    for (int e = 0; e < 8; ++e) { bias[e] = cb[c0 + e];
#pragma unroll
        for (int k = 0; k < 4; ++k) wgt[k][e] = cw[k * 1536 + c0 + e]; }
    u32x4 raw[11];
#pragma unroll
    for (int k = 0; k < 11; ++k) { const int t = tg0 - 3 + k; raw[k] = (t >= 0) ? *(const u32x4*)(xbc + (size_t)t * NPROJ + c0) : (u32x4){0u, 0u, 0u, 0u}; }
    float prev[8];
#pragma unroll
    for (int l = 0; l < 8; ++l) {
        float y[8];
#pragma unroll
        for (int e = 0; e < 8; ++e) y[e] = bias[e];
#pragma unroll
        for (int k = 0; k < 4; ++k) { float v[8]; unpack8(raw[l + k], v);
#pragma unroll
            for (int e = 0; e < 8; ++e) y[e] += wgt[k][e] * v[e]; }
#pragma unroll
        for (int e = 0; e < 8; ++e) y[e] = siluf(y[e]);
        if (TRANS) {
            if (l & 1) {
#pragma unroll
                for (int e = 0; e < 8; ++e) out[e][l >> 1] = pk2(prev[e], y[e]);
            } else {
#pragma unroll
                for (int e = 0; e < 8; ++e) prev[e] = y[e];
            }
        } else out[l] = pack8(y);
    }
}
__device__ __forceinline__ float softplusf(float x) { return fmaxf(x, 0.f) + log1pf(__expf(-fabsf(x))); }

__device__ __forceinline__ float ssd_dt_load(const Params& P, int b, int t0, int h, int lane) {
    const float* dtb = (const float*)(P.ws + WS_DT);
    return dtb[(size_t)(b * T + t0 + lane) * 16 + h];
}
__device__ __forceinline__ void ssd_dt(const Params& P, float rawv, int h, int lane, float& dt, float& acum, float& atot) {
    const float raw = rawv + P.in[5][h];
    dt = softplusf(raw);
    const float a = -__expf(P.in[6][h]);
    float x = dt * a;
#pragma unroll
    for (int o = 1; o < 64; o <<= 1) { const float y = __shfl_up(x, o); if (lane >= o) x += y; }
    acum = x; atot = __shfl(x, 63);
}

__device__ __forceinline__ void ssd_pass_a(const Params& P, LAS unsigned char* lds, int unit) {
    const int tid = threadIdx.x, lane = tid & 63, w = __builtin_amdgcn_readfirstlane(tid >> 6), g = lane >> 4, i = lane & 15;
    const int grp = unit & 1, c = (unit >> 1) & 63, b = unit >> 7, t0 = c * 64, h = grp * 8 + w;
    const bf16_t* proj = (const bf16_t*)(P.ws + WS_PROJ);
    const bf16_t* xbc = proj + (size_t)(b * T) * NPROJ + C_XBC;
    LAS bf16_t* XT = (LAS bf16_t*)lds; LAS bf16_t* BT = XT + 512 * 72; LAS float* WST = (LAS float*)(lds + 92160);
    const float dtraw = ssd_dt_load(P, b, t0, h, lane);
    __syncthreads();
    { const int cgi = tid & 63, lseg = tid >> 6; u32x4 o[8]; conv_item<true>(xbc, t0 + 8 * lseg, grp * 512 + 8 * cgi, P.in[3], P.in[4], o);
#pragma unroll
      for (int e = 0; e < 8; ++e) *(LAS u32x4*)(XT + (8 * cgi + e) * 72 + 8 * lseg) = o[e]; }
    if (tid < 128) { const int cgi = tid & 15, lseg = tid >> 4; u32x4 o[8]; conv_item<true>(xbc, t0 + 8 * lseg, 1024 + grp * 128 + 8 * cgi, P.in[3], P.in[4], o);
#pragma unroll
      for (int e = 0; e < 8; ++e) *(LAS u32x4*)(BT + (8 * cgi + e) * 72 + 8 * lseg) = o[e]; }
    { float dt, acum, atot; ssd_dt(P, dtraw, h, lane, dt, acum, atot);
      WST[w * 64 + lane] = dt * __expf(atot - acum);
      if (lane == 0) ((float*)(P.ws + WS_CD))[(b * 64 + c) * 16 + h] = __expf(atot); }
    __syncthreads();
    bf16_t* st = (bf16_t*)P.out + (size_t)((b * 64 + c) * 16 + h) * 8192;
#pragma unroll 1
    for (int pt = 0; pt < 4; ++pt) {
        bf16x8 xf[2];
#pragma unroll
        for (int ks = 0; ks < 2; ++ks) { const u32x4 raw = *(const LAS u32x4*)(XT + (w * 64 + 16 * pt + i) * 72 + 32 * ks + 8 * g); float v[8]; unpack8(raw, v);
            const f32x4 s0 = *(const LAS f32x4*)(WST + w * 64 + 32 * ks + 8 * g), s1 = *(const LAS f32x4*)(WST + w * 64 + 32 * ks + 8 * g + 4);
            v[0] *= s0[0]; v[1] *= s0[1]; v[2] *= s0[2]; v[3] *= s0[3]; v[4] *= s1[0]; v[5] *= s1[1]; v[6] *= s1[2]; v[7] *= s1[3];
            xf[ks] = as_frag(pack8(v)); }
#pragma unroll
        for (int nt = 0; nt < 8; ++nt) { f32x4 cacc = (f32x4){0.f, 0.f, 0.f, 0.f};
#pragma unroll
            for (int ks = 0; ks < 2; ++ks) { const bf16x8 af = *(const LAS bf16x8*)(BT + (16 * nt + i) * 72 + 32 * ks + 8 * g); cacc = mfma16(af, xf[ks], cacc); }
            u32x2 pkd; pkd.x = pk2(cacc[0], cacc[1]); pkd.y = pk2(cacc[2], cacc[3]);
            *(u32x2*)(st + (16 * pt + i) * 128 + 16 * nt + 4 * g) = pkd; }
    }
}

__device__ __forceinline__ void ssd_scan(const Params& P, int G) {
    bf16_t* ST = (bf16_t*)P.out; const float* CD = (const float*)(P.ws + WS_CD);
    for (int v = blockIdx.x * 512 + threadIdx.x; v < BATCH * 16 * 8192 / 8; v += G * 512) {
        const int e = v * 8, off = e & 8191, h = (e >> 13) & 15, b = e >> 17;
        float run[8];
#pragma unroll
        for (int k = 0; k < 8; ++k) run[k] = 0.f;
#pragma unroll 1
        for (int c0 = 0; c0 < 63; c0 += 9) {
            u32x4 raw[9]; float dec[9];
#pragma unroll
            for (int k = 0; k < 9; ++k) { raw[k] = *(const u32x4*)(ST + (size_t)((b * 64 + c0 + k) * 16 + h) * 8192 + off); dec[k] = CD[(b * 64 + c0 + k) * 16 + h]; }
#pragma unroll
            for (int k = 0; k < 9; ++k) { float sv[8]; unpack8(raw[k], sv);
#pragma unroll
                for (int q = 0; q < 8; ++q) run[q] = run[q] * dec[k] + sv[q];
                *(u32x4*)(ST + (size_t)((b * 64 + c0 + k) * 16 + h) * 8192 + off) = pack8(run); }
        }
    }
}

__device__ __forceinline__ void ssd_pass_c(const Params& P, LAS unsigned char* lds, int unit) {
    const int tid = threadIdx.x, lane = tid & 63, w = __builtin_amdgcn_readfirstlane(tid >> 6), g = lane >> 4, i = lane & 15;
    const int grp = unit & 1, c = (unit >> 1) & 63, b = unit >> 7, t0 = c * 64, h = grp * 8 + w;
    const bf16_t* proj = (const bf16_t*)(P.ws + WS_PROJ);
    const bf16_t* xbc = proj + (size_t)(b * T) * NPROJ + C_XBC;
    LAS bf16_t* XT = (LAS bf16_t*)lds; LAS bf16_t* Bn = (LAS bf16_t*)(lds + 73728); LAS bf16_t* Cn = (LAS bf16_t*)(lds + 91136);
    LAS float* CB = (LAS float*)(lds + 108544); LAS float* ACUM = (LAS float*)(lds + 125952); LAS float* DTV = (LAS float*)(lds + 128000); LAS float* SSQ = (LAS float*)(lds + 130048);
    const float dtraw = ssd_dt_load(P, b, t0, h, lane);
    __syncthreads();
    { const int cgi = tid & 63, lseg = tid >> 6; u32x4 o[8]; conv_item<true>(xbc, t0 + 8 * lseg, grp * 512 + 8 * cgi, P.in[3], P.in[4], o);
#pragma unroll
      for (int e = 0; e < 8; ++e) *(LAS u32x4*)(XT + (8 * cgi + e) * 72 + 8 * lseg) = o[e]; }
    if (tid < 256) { const int cgi = tid & 31, lseg = tid >> 5; const int isC = cgi >> 4, cc = cgi & 15; u32x4 o[8];
      conv_item<false>(xbc, t0 + 8 * lseg, 1024 + isC * 256 + grp * 128 + 8 * cc, P.in[3], P.in[4], o);
      LAS bf16_t* dst = (isC ? Cn : Bn) + (8 * lseg) * 136 + 8 * cc;
#pragma unroll
      for (int l = 0; l < 8; ++l) *(LAS u32x4*)(dst + l * 136) = o[l]; }
    { float dt, acum, atot; ssd_dt(P, dtraw, h, lane, dt, acum, atot); ACUM[w * 64 + lane] = acum; DTV[w * 64 + lane] = dt; }
    u32x4 pfr[4][4];
    if (c > 0) { const bf16_t* prev = (const bf16_t*)P.out + (size_t)((b * 64 + c - 1) * 16 + h) * 8192;
#pragma unroll
        for (int pt = 0; pt < 4; ++pt)
#pragma unroll
            for (int ks = 0; ks < 4; ++ks) pfr[pt][ks] = *(const u32x4*)(prev + (16 * pt + i) * 128 + 32 * ks + 8 * g); }
    __syncthreads();
    { const int lt = w >> 1;
#pragma unroll
      for (int q = 0; q < 2; ++q) { const int st = (w & 1) * 2 + q; f32x4 cacc = (f32x4){0.f, 0.f, 0.f, 0.f};
#pragma unroll
        for (int ks = 0; ks < 4; ++ks) { const bf16x8 af = *(const LAS bf16x8*)(Cn + (16 * lt + i) * 136 + 32 * ks + 8 * g), bfr = *(const LAS bf16x8*)(Bn + (16 * st + i) * 136 + 32 * ks + 8 * g); cacc = mfma16(af, bfr, cacc); }
#pragma unroll
        for (int r = 0; r < 4; ++r) CB[(16 * lt + 4 * g + r) * 68 + 16 * st + i] = cacc[r]; } }
    u32x2 zreg[4][4];
#pragma unroll
    for (int lt = 0; lt < 4; ++lt) { const bf16_t* zrow = proj + (size_t)(b * T + t0 + 16 * lt + i) * NPROJ + C_Z + h * 64 + 4 * g;
#pragma unroll
        for (int pt = 0; pt < 4; ++pt) zreg[lt][pt] = *(const u32x2*)(zrow + 16 * pt); }
    __syncthreads();
    f32x4 acc[4][4];
#pragma unroll
    for (int lt = 0; lt < 4; ++lt)
#pragma unroll
        for (int pt = 0; pt < 4; ++pt) acc[lt][pt] = (f32x4){0.f, 0.f, 0.f, 0.f};
    if (c > 0) {
#pragma unroll
        for (int pt = 0; pt < 4; ++pt)
#pragma unroll
            for (int ks = 0; ks < 4; ++ks) { const bf16x8 pf_ = as_frag(pfr[pt][ks]);
#pragma unroll
                for (int lt = 0; lt < 4; ++lt) { const bf16x8 cf = *(const LAS bf16x8*)(Cn + (16 * lt + i) * 136 + 32 * ks + 8 * g); acc[lt][pt] = mfma16(pf_, cf, acc[lt][pt]); } }
#pragma unroll
        for (int lt = 0; lt < 4; ++lt) { const float sc = __expf(ACUM[w * 64 + 16 * lt + i]);
#pragma unroll
            for (int pt = 0; pt < 4; ++pt) acc[lt][pt] = acc[lt][pt] * sc; }
    }
    const float dsk = P.in[7][h];
#pragma unroll
    for (int lt = 0; lt < 4; ++lt)
#pragma unroll
        for (int ks2 = 0; ks2 < 2; ++ks2) {
            if (32 * ks2 <= 16 * lt + 15) {
                const int l = 16 * lt + i; const float al = ACUM[w * 64 + l];
                const f32x4 c0 = *(const LAS f32x4*)(CB + l * 68 + 32 * ks2 + 8 * g), c1 = *(const LAS f32x4*)(CB + l * 68 + 32 * ks2 + 8 * g + 4);
                const f32x4 a0 = *(const LAS f32x4*)(ACUM + w * 64 + 32 * ks2 + 8 * g), a1 = *(const LAS f32x4*)(ACUM + w * 64 + 32 * ks2 + 8 * g + 4);
                const f32x4 d0 = *(const LAS f32x4*)(DTV + w * 64 + 32 * ks2 + 8 * g), d1 = *(const LAS f32x4*)(DTV + w * 64 + 32 * ks2 + 8 * g + 4);
                float v[8];
#pragma unroll
                for (int e = 0; e < 8; ++e) { const int sidx = 32 * ks2 + 8 * g + e; const float cbv = e < 4 ? c0[e & 3] : c1[e & 3], as = e < 4 ? a0[e & 3] : a1[e & 3], ds = e < 4 ? d0[e & 3] : d1[e & 3];
                    v[e] = (sidx <= l) ? cbv * __expf(fminf(al - as, 0.f)) * ds : 0.f;
                    if (sidx == l) v[e] += dsk; }
                const bf16x8 mf = as_frag(pack8(v));
#pragma unroll
                for (int pt = 0; pt < 4; ++pt) { const bf16x8 xf = *(const LAS bf16x8*)(XT + (w * 64 + 16 * pt + i) * 72 + 32 * ks2 + 8 * g); acc[lt][pt] = mfma16(xf, mf, acc[lt][pt]); }
            }
        }
#pragma unroll
    for (int lt = 0; lt < 4; ++lt) { const int l = 16 * lt + i; float rss = 0.f;
#pragma unroll
        for (int pt = 0; pt < 4; ++pt) { const u32x2 zr = zreg[lt][pt];
            const float z[4] = {bflo(zr.x), bfhi(zr.x), bflo(zr.y), bfhi(zr.y)};
#pragma unroll
            for (int r = 0; r < 4; ++r) { const float y = acc[lt][pt][r] * siluf(z[r]); acc[lt][pt][r] = y; rss += y * y; } }
        rss += __shfl_xor(rss, 16); rss += __shfl_xor(rss, 32);
        if (g == 0) SSQ[w * 64 + l] = rss; }
    __syncthreads();
    bf16_t* Y = (bf16_t*)(P.ws + WS_Y);
    const float* nw = P.in[8] + h * 64;
    f32x4 nwv[4];
#pragma unroll
    for (int pt = 0; pt < 4; ++pt) nwv[pt] = *(const f32x4*)(nw + 16 * pt + 4 * g);
#pragma unroll
    for (int lt = 0; lt < 4; ++lt) { const int l = 16 * lt + i; float tot = 0.f;
#pragma unroll
        for (int ww = 0; ww < 8; ++ww) tot += SSQ[ww * 64 + l];
        const float rs = rsqrtf(tot * (1.0f / 512.0f) + EPS);
        bf16_t* yrow = Y + (size_t)(b * T + t0 + l) * NMIX + h * 64 + 4 * g;
#pragma unroll
        for (int pt = 0; pt < 4; ++pt) { const f32x4 n4 = nwv[pt]; const f32x4 v = acc[lt][pt] * rs * n4;
            u32x2 pkd; pkd.x = pk2(v[0], v[1]); pkd.y = pk2(v[2], v[3]); *(u32x2*)(yrow + 16 * pt) = pkd; } }
}

__device__ __forceinline__ void swa_phase(const Params& P, LAS unsigned char* lds, int G) {
    constexpr int KP = 72, VP = 80, BUF = 64 * KP * 2 + 64 * VP * 2;
    const int tid = threadIdx.x, lane = tid & 63, w = __builtin_amdgcn_readfirstlane(tid >> 6), g = lane >> 4, i = lane & 15;
    const int krow = tid >> 3, kseg = tid & 7, half = w >> 2;
    u32x4 kr[4], vr[4], qr[4][2];
#define SWA_LOAD(uu) do { const int qb_ = (uu) & 31, kvh_ = ((uu) >> 5) & 3, b_ = (uu) >> 7; const bf16_t* proj_ = (const bf16_t*)(P.ws + WS_PROJ) + (size_t)(b_ * T) * NPROJ; \
        const bf16_t* Kg_ = proj_ + C_K + kvh_ * 64; const bf16_t* Vg_ = proj_ + C_V + kvh_ * 64; const int jlo_ = (2 * qb_ - 2 > 0) ? 2 * qb_ - 2 : 0, jhi_ = 2 * qb_ + 1; \
        _Pragma("unroll") for (int t = 0; t < 4; ++t) if (jlo_ + t <= jhi_) { kr[t] = *(const u32x4*)(Kg_ + (size_t)((jlo_ + t) * 64 + krow) * NPROJ + 8 * kseg); vr[t] = *(const u32x4*)(Vg_ + (size_t)((jlo_ + t) * 64 + krow) * NPROJ + 8 * kseg); } \
        const bf16_t* qrow_ = proj_ + (size_t)(qb_ * 128 + 16 * w + i) * NPROJ + C_Q + kvh_ * 256; \
        _Pragma("unroll") for (int a = 0; a < 4; ++a) { qr[a][0] = *(const u32x4*)(qrow_ + a * 64 + 8 * g); qr[a][1] = *(const u32x4*)(qrow_ + a * 64 + 32 + 8 * g); } } while (0)
    int u = blockIdx.x;
    if (u < 1024) SWA_LOAD(u);
    for (; u < 1024; u += G) {
        const int qb = u & 31, kvh = (u >> 5) & 3, b = u >> 7;
        const int jlo = (2 * qb - 2 > 0) ? 2 * qb - 2 : 0, jhi = 2 * qb + 1;
        int wlo = 2 * qb - 2 + half; if (wlo < 0) wlo = 0; const int whi = 2 * qb + half;
        __syncthreads();
#pragma unroll
        for (int t = 0; t < 4; ++t) if (jlo + t <= jhi) { *(LAS u32x4*)(lds + t * BUF + (krow * KP + 8 * kseg) * 2) = kr[t]; *(LAS u32x4*)(lds + t * BUF + 64 * KP * 2 + (krow * VP + 8 * kseg) * 2) = vr[t]; }
        u32x4 qc[4][2];
#pragma unroll
        for (int a = 0; a < 4; ++a) { qc[a][0] = qr[a][0]; qc[a][1] = qr[a][1]; asm volatile("" : "+v"(qc[a][0]), "+v"(qc[a][1])); }
        __syncthreads();
        if (u + G < 1024) SWA_LOAD(u + G);
        const int qrel = qb * 128 + 16 * w + i;
#pragma unroll
        for (int pr = 0; pr < 2; ++pr) {
            const int h0 = kvh * 4 + pr * 2;
            bf16x8 qf[2][2]; f32x4 acc[2][4]; float lrun[2], slope2v[2];
#pragma unroll
            for (int a = 0; a < 2; ++a) { const int h = h0 + a; qf[a][0] = as_frag(qc[2 * pr + a][0]); qf[a][1] = as_frag(qc[2 * pr + a][1]);
                slope2v[a] = exp2f(-0.5f * (float)(h + 1)) * LOG2E; lrun[a] = (g == 0) ? exp2f(P.in[11][h] * LOG2E) : 0.f;
#pragma unroll
                for (int dt = 0; dt < 4; ++dt) acc[a][dt] = (f32x4){0.f, 0.f, 0.f, 0.f}; }
            for (int j = wlo; j <= whi; ++j) attn_tile<2, 1, 64>(lds + (j - jlo) * BUF, qf, acc, lrun, slope2v, qrel, j, j == whi, g, i);
            bf16_t* orow = (bf16_t*)(P.ws + WS_Y) + (size_t)(b * T + qb * 128 + 16 * w + i) * NMIX + 1024 + h0 * 64;
#pragma unroll
            for (int a = 0; a < 2; ++a) { float l = lrun[a]; l += __shfl_xor(l, 16); l += __shfl_xor(l, 32); const float i0 = 1.0f / l;
#pragma unroll
                for (int dt = 0; dt < 4; ++dt) { const f32x4 v = acc[a][dt] * i0; u32x2 pkd; pkd.x = pk2(v[0], v[1]); pkd.y = pk2(v[2], v[3]); *(u32x2*)(orow + a * 64 + 16 * dt + 4 * g) = pkd; } }
        }
    }
#undef SWA_LOAD
}
__device__ __forceinline__ void diff_phase_unit(const Params& P, LAS unsigned char* lds, int bh, int qb, float lam, float thr2) {
    const int w = __builtin_amdgcn_readfirstlane(threadIdx.x >> 6);
    const int h = bh & 7, b = bh >> 3;
    const bf16_t* qkv = (const bf16_t*)(P.ws + WS_PROJ) + (size_t)(b * T) * NQKV;
    bf16_t* O = (bf16_t*)(P.ws + WS_Y) + (size_t)(b * T + qb * 128) * D + h * 128;
    const int half = w >> 2;
    const float sl = exp2f(-(float)(h + 1)) * LOG2E;
    const float slope2v[2] = {sl, sl}, linit[2] = {0.f, 0.f};
    const float lam_init = 0.8f - 0.6f * 0.7408182206817179f;
    const float dreq = thr2 / sl;
    const int kb = (dreq < 8192.f) ? (int)floorf((dreq + 63.0f) * (1.0f / 64.0f)) + 1 : 1 << 20;
    int jlo = 2 * qb - kb + 1; if (jlo < 0) jlo = 0;
    int wlo = 2 * qb + half - kb + 1; if (wlo < 0) wlo = 0;
    attn_unit<2, 2, 128>(lds, qkv + (size_t)(qb * 128) * NQKV + h * 128, qkv + 1024 + h * 128, qkv + 2048 + h * 128, NQKV,
                         qb * 128, jlo, 2 * qb + 1, wlo, 2 * qb + half, slope2v, linit, O, D, lam, P.in[21], 1.0f - lam_init);
}

typedef __attribute__((address_space(1))) unsigned gu32;
constexpr size_t WS_BAR = 576 * 1024;
constexpr int LDS_MISC = 147456 - 64;
#define XB_TMO      128
#define XB_XCNT(j)  (256  + 64 * (j))
#define XB_XSUB(j)  (1280 + 64 * (j))
#define XB_XGEN(j)  (2304 + 64 * (j))
#define XB_TOP      3328
#define XB_TOPGEN   3392
#define XCD_BAR_WORDS 3456
#define XB_SPIN_CAP (1u << 23)

__device__ __forceinline__ unsigned xb_ld(unsigned* p)              { return __hip_atomic_load(p, __ATOMIC_RELAXED, __HIP_MEMORY_SCOPE_AGENT); }
__device__ __forceinline__ unsigned xb_add(unsigned* p, unsigned v) { return __hip_atomic_fetch_add(p, v, __ATOMIC_RELAXED, __HIP_MEMORY_SCOPE_AGENT); }
__device__ __forceinline__ unsigned xb_xcc_id() { return (unsigned)__builtin_amdgcn_s_getreg((3 << 11) | 20) & 0xFu; }
#define XB_SPIN(cond, bar) do { unsigned _sp = 0; while (cond) { __builtin_amdgcn_s_sleep(1); \
    if ((++_sp & 255u) == 0u) { if (xb_ld(&(bar)[XB_TMO])) break; if (_sp > XB_SPIN_CAP) { atomicAdd(&(bar)[XB_TMO], 1u); break; } } } } while (0)

struct XcdBarrier {
    unsigned* bar; unsigned x;
    volatile LAS unsigned* st;
};

__device__ __forceinline__ XcdBarrier xcd_barrier_post(unsigned* bar, volatile LAS unsigned* st) {
    XcdBarrier b; b.bar = bar; b.x = xb_xcc_id(); b.st = st;
    if (threadIdx.x == 0) (void)xb_add(&bar[XB_XCNT(b.x)], 1u);
    return b;
}
__device__ __forceinline__ void xcd_barrier_complete(unsigned* bar, unsigned x, unsigned& nloc, unsigned& nx) {
    const unsigned G = gridDim.x * gridDim.y * gridDim.z;
    unsigned sum, cnt, mine, sp = 0u;
    for (;;) {
        sum = 0u; cnt = 0u; mine = 0u;
#pragma unroll
        for (unsigned j = 0; j < 16; ++j) { const unsigned c = xb_ld(&bar[XB_XCNT(j)]); sum += c; cnt += (c > 0u) ? 1u : 0u; mine = (j == x) ? c : mine; }
        if (sum == G) break;
        __builtin_amdgcn_s_sleep(1);
        if ((++sp & 255u) == 0u) { if (xb_ld(&bar[XB_TMO])) break; if (sp > XB_SPIN_CAP) { atomicAdd(&bar[XB_TMO], 1u); break; } }
    }
    nloc = mine > 0u ? mine : 1u; nx = cnt > 0u ? cnt : 1u;
}

__device__ __forceinline__ void xcd_barrier(const XcdBarrier& b) {
    asm volatile("s_waitcnt vmcnt(0)" ::: "memory");
    __syncthreads();
    if (threadIdx.x == 0) {
        unsigned* bar = b.bar;
        __builtin_amdgcn_s_waitcnt(0);
        unsigned nloc = b.st[0], nx = b.st[1];
        if (nloc == 0u) { xcd_barrier_complete(bar, b.x, nloc, nx); b.st[0] = nloc; b.st[1] = nx; }
        const unsigned old = xb_add(&bar[XB_XSUB(b.x)], 1u);
        const unsigned gen = old / nloc;
        if (old + 1u == (gen + 1u) * nloc) {
            __builtin_amdgcn_fence(__ATOMIC_RELEASE, "agent");
            asm volatile("s_waitcnt vmcnt(0)" ::: "memory");
            const unsigned og = xb_add(&bar[XB_TOP], 1u);
            const unsigned tg = og / nx;
            if (og + 1u == (tg + 1u) * nx) xb_add(&bar[XB_TOPGEN], 1u);
            else XB_SPIN(xb_ld(&bar[XB_TOPGEN]) == tg, bar);
            __builtin_amdgcn_fence(__ATOMIC_ACQUIRE, "agent");
            xb_add(&bar[XB_XGEN(b.x)], 1u);
            asm volatile("s_waitcnt vmcnt(0)" ::: "memory");
        } else {
            XB_SPIN(xb_ld(&bar[XB_XGEN(b.x)]) == gen, bar);
            __builtin_amdgcn_fence(__ATOMIC_ACQUIRE, "agent");
            asm volatile("s_waitcnt vmcnt(0)" ::: "memory");
        }
    }
    __syncthreads();
}

__global__ void __launch_bounds__(512) fwd_kernel(Params P) {
    extern __shared__ __attribute__((aligned(16))) unsigned char lds_raw[];
    LAS unsigned char* lds = (LAS unsigned char*)lds_raw;
    const int G = gridDim.x;
    unsigned char* ws = P.ws;
    float* ssq = (float*)(ws + WS_SSQ);
    bf16_t* XB = (bf16_t*)(ws + WS_XB);
    bf16_t* BIG = (bf16_t*)(ws + WS_PROJ);
    bf16_t* YB = (bf16_t*)(ws + WS_Y);
    const int lo = P.ph_lo, hi = P.ph_hi;
    if (threadIdx.x < 2) ((volatile LAS unsigned*)(lds + LDS_MISC))[threadIdx.x] = 0u;
    __syncthreads();
    XcdBarrier xbar; xbar.bar = (unsigned*)(ws + WS_BAR); xbar.x = 0; xbar.st = (volatile LAS unsigned*)(lds + LDS_MISC);
    if (hi - lo > 1) xbar = xcd_barrier_post((unsigned*)(ws + WS_BAR), (volatile LAS unsigned*)(lds + LDS_MISC));
    if (hi > 1000) cg::this_grid().sync();
#define IN(k) (lo <= (k) && (k) < hi)
#define SEAM(k) do { if (IN(k) && IN((k) + 1)) xcd_barrier(xbar); } while (0)
#define GEMM_STORE(ACT, NRM, Wt, NN, LDC, NCOLS, SSQ, QW, KW) do { pg8::Gemm g{XB, (const bf16_t*)(Wt), M, NN, D}; pg8::EpiStore<ACT, NRM> E{BIG, LDC, NCOLS, SSQ, (float*)(ws + WS_DT), QW, KW}; \
        pg8::StaticOrder S; S.init(M, NN, G, (int)blockIdx.x); pg8::gemm_phase<pg8::EpiStore<ACT, NRM>, pg8::StaticOrder, true, true>(lds, g, S, E); } while (0)
#define GEMM_RES(RESF, OUTF, SCALE, A, Wt, KK, SSQ, SSQIN) do { pg8::Gemm g{A, (const bf16_t*)(Wt), M, D, KK}; pg8::EpiRes<RESF, OUTF, SCALE> E{P.in[0], XB, P.out, SSQ, SSQIN}; \
        pg8::StaticOrder S; S.init(M, D, G, (int)blockIdx.x); pg8::gemm_phase<pg8::EpiRes<RESF, OUTF, SCALE>, pg8::StaticOrder, true, true>(lds, g, S, E); } while (0)
    if (IN(0)) p0_prologue(P, lds, G);
    SEAM(0);
    if (IN(1)) GEMM_STORE(0, 1, ws + WS_WIN, 4096, NPROJ, 4096, ssq, P.in[9], P.in[10]);
    SEAM(1);
    if (IN(2)) {
        for (int u = blockIdx.x; u < 1024; u += G) ssd_pass_a(P, lds, u);
        swa_phase(P, lds, G);
        __syncthreads();
    }
    SEAM(2);
    if (IN(3)) ssd_scan(P, G);
    SEAM(3);
    if (IN(4)) { for (int u = blockIdx.x; u < 1024; u += G) ssd_pass_c(P, lds, u); __syncthreads(); }
    SEAM(4);
    if (IN(5)) GEMM_RES(false, false, false, YB, ws + WS_WOE, NMIX, ssq + M, (const float*)nullptr);
    SEAM(5);
    if (IN(6)) GEMM_STORE(1, 0, ws + WS_W1, FF, FF, FF, ssq + M, (const float*)nullptr, (const float*)nullptr);
    SEAM(6);
    if (IN(7)) GEMM_RES(false, false, true, BIG, ws + WS_W2, FF, ssq + 2 * M, (const float*)(ssq + M));
    SEAM(7);
    if (IN(8)) GEMM_STORE(0, 2, ws + WS_WQKV, NQKV, NQKV, NQKV, ssq + 2 * M, P.in[15], P.in[16]);
    SEAM(8);
    if (IN(9)) {
        float l1 = 0.f, l2 = 0.f;
        for (int e = 0; e < 64; ++e) { l1 += P.in[17][e] * P.in[18][e]; l2 += P.in[19][e] * P.in[20][e]; }
        const float lam = __expf(l1) - __expf(l2) + (0.8f - 0.6f * 0.7408182206817179f);
        float mq = 0.f, mk = 0.f;
        for (int e = 0; e < 64; ++e) { mq = fmaxf(mq, fabsf(P.in[15][e])); mk = fmaxf(mk, fabsf(P.in[16][e])); }
        const float thr2 = 152.0f + 2.0f * (8.0f * LOG2E * mq * mk * 1.01f);
        if (G == 256) {
            const int xcd = blockIdx.x & 7, cu = blockIdx.x >> 3;
            LAS unsigned char* ord = (LAS unsigned char*)(lds + 147456 - 1024);
            __syncthreads();
            if (threadIdx.x < 256) {
                const int t = threadIdx.x; int rank = 0;
                auto work = [&](int uu) { const int hh = uu >> 5, qq = uu & 31; const float sl_ = exp2f(-(float)(hh + 1)) * LOG2E; const float dreq_ = thr2 / sl_;
                    const int kb_ = (dreq_ < 8192.f) ? (int)floorf((dreq_ + 63.0f) * (1.0f / 64.0f)) + 1 : 1 << 20; int jl = 2 * qq - kb_ + 1; if (jl < 0) jl = 0; return 2 * qq + 2 - jl; };
                const int wt = work(t);
                for (int o = 0; o < 256; ++o) { const int wo = work(o); rank += (wo > wt || (wo == wt && o < t)) ? 1 : 0; }
                ord[rank] = (unsigned char)t;
            }
            __syncthreads();
            for (int r = 0; r < 8; ++r) { const int uu = __builtin_amdgcn_readfirstlane((int)ord[r * 32 + ((r & 1) ? 31 - cu : cu)]); const int bh = xcd * 8 + (uu >> 5), qb = uu & 31; __syncthreads(); diff_phase_unit(P, lds, bh, qb, lam, thr2); }
        } else {
            const int nround = (2048 + G - 1) / G;
            for (int it = 0; it < nround; ++it) {
                int u = it * G + (int)blockIdx.x; if (u >= 2048) break;
                const int bh = u & 63; int k = u >> 6;
                const int grp4 = k >> 2, sub = k & 3; const int qb = 31 - (4 * grp4 + ((grp4 & 1) ? 3 - sub : sub));
                __syncthreads(); diff_phase_unit(P, lds, bh, qb, lam, thr2);
            }
        }
        __syncthreads();
    }
    SEAM(9);
    if (IN(10)) GEMM_RES(false, false, false, YB, ws + WS_WOO, D, ssq + 3 * M, (const float*)nullptr);
    SEAM(10);
    if (IN(11)) GEMM_STORE(1, 0, ws + WS_W1 + 8 * MiB, FF, FF, FF, ssq + 3 * M, (const float*)nullptr, (const float*)nullptr);
    SEAM(11);
    if (IN(12)) GEMM_RES(false, true, true, BIG, ws + WS_W2 + 8 * MiB, FF, (float*)nullptr, (const float*)(ssq + 3 * M));
}

extern "C" void kernel_launch(void* const* d_in, const int* in_sizes, int n_in, void* d_out, int out_size, void* d_ws, size_t ws_size, hipStream_t stream) {
    static int grid = 0;
    if (grid == 0) {
        if (n_in != 26 || out_size != M * D || ws_size < WS_END) { fprintf(stderr, "kernel_launch: unexpected problem (n_in %d, out %d, ws %zu)\n", n_in, out_size, ws_size); grid = -1; return; }
        int dev = 0, cus = 0, per_cu = 0;
        hipGetDevice(&dev); hipDeviceGetAttribute(&cus, hipDeviceAttributeMultiprocessorCount, dev);
        if (hipFuncSetAttribute((const void*)fwd_kernel, hipFuncAttributeMaxDynamicSharedMemorySize, LDS_BYTES) != hipSuccess) { fprintf(stderr, "kernel_launch: hipFuncSetAttribute failed\n"); grid = -1; return; }
        if (hipOccupancyMaxActiveBlocksPerMultiprocessor(&per_cu, (const void*)fwd_kernel, 512, LDS_BYTES) != hipSuccess || per_cu < 1) { fprintf(stderr, "kernel_launch: occupancy query says %d\n", per_cu); per_cu = 1; }
        (void)hipGetLastError();
        grid = cus * 1;
        if (grid <= 0) grid = 256;
    }
    if (grid < 0) return;
    Params p{};
    for (int i = 0; i < 26; ++i) p.in[i] = (const float*)d_in[i];
    p.out = (float*)d_out; p.ws = (unsigned char*)d_ws;
#if ONE_LAUNCH
    p.ph_lo = 0; p.ph_hi = NPHASE;
    if (hipMemsetAsync((unsigned char*)d_ws + WS_BAR, 0, XCD_BAR_WORDS * 4, stream) != hipSuccess) { fprintf(stderr, "kernel_launch: memset of the barrier words failed\n"); return; }
    void* args[] = {&p};
    hipError_t e = hipLaunchCooperativeKernel((const void*)fwd_kernel, dim3(grid), dim3(512), args, LDS_BYTES, stream);
    if (e != hipSuccess) fprintf(stderr, "cooperative launch failed: %s (grid %d)\n", hipGetErrorString(e), grid);
#else
    for (int ph = 0; ph < NPHASE; ++ph) { p.ph_lo = ph; p.ph_hi = ph + 1; hipLaunchKernelGGL(fwd_kernel, dim3(grid), dim3(512), LDS_BYTES, stream, p); }
#endif
}
```

```cpp
#include <hip/hip_runtime.h>
#include <hip/hip_cooperative_groups.h>
#include <cstdio>
#include <cstdint>
namespace cg = cooperative_groups;
namespace pg8 {
#define PG8_LAS __attribute__((address_space(3)))
typedef unsigned short bf16_t;
typedef short bf16x8 __attribute__((ext_vector_type(8)));
typedef float f32x4 __attribute__((ext_vector_type(4)));
typedef unsigned u32x4 __attribute__((ext_vector_type(4)));
constexpr int BM = 256, BK = 64, HALF = 128, HTB = HALF * BK * 2  , STAGE_BYTES = 8 * HTB, NXCD = 8, WGM = 8;

__host__ __device__ __forceinline__ int lds_byte(int r, int c) { const int st = (r >> 4) * 2 + (c >> 5), rr = r & 15, cc = c & 31, ob = rr * 64 + cc * 2; return st * 1024 + (ob ^ (((ob >> 9) & 1) << 5)); }
__host__ __device__ __forceinline__ void stage_rc(int b, int& R, int& C) { const int st = b / 1024, sb = b % 1024, swz = sb ^ (((sb >> 9) & 1) << 5); R = (st >> 1) * 16 + swz / 64; C = (st & 1) * 32 + (swz % 64) / 2; }
__host__ __device__ __forceinline__ int perm32(int rho) { const int n = rho >> 4, i = rho & 15; return 8 * (i >> 2) + 4 * n + (i & 3); }

struct Unit { int pm, pn; };
struct Gemm { const bf16_t* A; const bf16_t* Bt; int M, N, K; };

struct StaticOrder {
    int nM, nN, nwg, G, c;
    __host__ __device__ void init(int M, int N, int G_, int c_) { nM = M / BM; nN = N / BM; nwg = nM * nN; G = G_; c = c_; }
    __host__ __device__ bool next(int i, Unit& u) const {
        const long L = (long)i * G + c; if (L >= nwg) return false;
        int wgid = (int)L; { const int q = nwg / NXCD, r = nwg % NXCD, xcd = wgid % NXCD, off = wgid / NXCD; wgid = (xcd < r ? xcd * (q + 1) : r * (q + 1) + (xcd - r) * q) + off; }
        const int nig = WGM * nN, gid = wgid / nig, fm = gid * WGM, gsz = (nM - fm) < WGM ? (nM - fm) : WGM;
        u.pm = fm + ((wgid % nig) % gsz); u.pn = (wgid % nig) / gsz; return true;
    }
    __device__ __forceinline__ void a_ready(const Unit&) const {}
    __device__ __forceinline__ void done(const Unit&) const {}
};

__device__ __forceinline__ unsigned cvt_pk_bf16(float lo, float hi) { unsigned r; asm volatile("v_cvt_pk_bf16_f32 %0, %1, %2" : "=v"(r) : "v"(lo), "v"(hi)); return r; }
template <int ACT, int NRM> struct EpiStore {
    static constexpr bool PERM = true, AFTER_DRAIN = false;
    bf16_t* O; int ldc; int ncols; const float* ssq; float* dtb; const float* qw; const float* kw;
    __device__ __forceinline__ void operator()(const f32x4 (&acc)[2][2][4][2], const Unit& u, int wr, int wc, int fr, int fq) const {
        const int row0 = u.pm * BM + wr * 64 + fr;
        constexpr bool NOSCALE = (ACT == 1 && NRM == 0);
        float sq[2][4];
#pragma unroll
        for (int ai = 0; ai < 2; ++ai)
#pragma unroll
            for (int m = 0; m < 4; ++m) sq[ai][m] = NOSCALE ? 0.f : ssq[row0 + ai * HALF + m * 16];
        if constexpr (NRM == 0) {
            const int col0 = u.pn * BM + wc * 32 + 8 * fq;
#pragma unroll
            for (int ai = 0; ai < 2; ++ai)
#pragma unroll
                for (int m = 0; m < 4; ++m) { const int row = row0 + ai * HALF + m * 16; const float rs = NOSCALE ? 1.0f : rsqrtf(sq[ai][m] * (1.0f / 1024.0f) + 1e-6f);
                    bf16_t* rowp = O + (size_t)row * ldc;
#pragma unroll
                    for (int bj = 0; bj < 2; ++bj) { const int col = col0 + bj * HALF;
                        if (col < ncols) { f32x4 v0 = acc[ai][bj][m][0] * rs, v1 = acc[ai][bj][m][1] * rs;
                            if (ACT) { v0 = __builtin_elementwise_max(v0, (f32x4){0.f, 0.f, 0.f, 0.f}); v1 = __builtin_elementwise_max(v1, (f32x4){0.f, 0.f, 0.f, 0.f}); v0 = v0 * v0; v1 = v1 * v1; }
                            u32x4 w; w.x = cvt_pk_bf16(v0[0], v0[1]); w.y = cvt_pk_bf16(v0[2], v0[3]); w.z = cvt_pk_bf16(v1[0], v1[1]); w.w = cvt_pk_bf16(v1[2], v1[3]);
                            *(u32x4*)(rowp + col) = w; } } }
        } else {
            const int gbase = u.pn * BM + 64 * wc;
            int kind = 0;
            if (NRM == 1) kind = (gbase >= 2560 && gbase < 3584) ? 1 : ((gbase >= 3584 && gbase < 3840) ? 2 : 0);
            else kind = gbase < 1024 ? 1 : (gbase < 2048 ? 2 : 0);
            f32x4 wg[2][2];
#pragma unroll
            for (int bj = 0; bj < 2; ++bj)
#pragma unroll
                for (int n = 0; n < 2; ++n) wg[bj][n] = kind ? *(const f32x4*)((kind == 1 ? qw : kw) + 32 * bj + 8 * fq + 4 * n) : (f32x4){1.f, 1.f, 1.f, 1.f};
            const float post = kind == 1 ? 0.125f * 1.4426950408889634f : 1.0f;
#pragma unroll
            for (int ai = 0; ai < 2; ++ai)
#pragma unroll
                for (int m = 0; m < 4; ++m) { const int row = row0 + ai * HALF + m * 16; const float rs = rsqrtf(sq[ai][m] * (1.0f / 1024.0f) + 1e-6f);
                    bf16_t* rowp = O + (size_t)row * ldc;
                    f32x4 v[2][2]; float ss = 0.f;
#pragma unroll
                    for (int bj = 0; bj < 2; ++bj)
#pragma unroll
                        for (int n = 0; n < 2; ++n) { v[bj][n] = acc[ai][bj][m][n] * rs; ss += (v[bj][n][0] * v[bj][n][0] + v[bj][n][1] * v[bj][n][1]) + (v[bj][n][2] * v[bj][n][2] + v[bj][n][3] * v[bj][n][3]); }
                    if (kind) { ss += __shfl_xor(ss, 16); ss += __shfl_xor(ss, 32); const float rn = rsqrtf(ss * (1.0f / 64.0f) + 1e-6f) * post;
#pragma unroll
                        for (int bj = 0; bj < 2; ++bj)
#pragma unroll
                            for (int n = 0; n < 2; ++n) v[bj][n] = v[bj][n] * rn * wg[bj][n]; }
#pragma unroll
                    for (int bj = 0; bj < 2; ++bj) { const int col = gbase + 32 * bj + 8 * fq;
                        if (col < ncols) {
                            if (NRM == 1 && col >= 4096) { float* dp = dtb + (size_t)row * 16 + (col - 4096); *(f32x4*)dp = v[bj][0]; *(f32x4*)(dp + 4) = v[bj][1]; }
                            u32x4 w; w.x = cvt_pk_bf16(v[bj][0][0], v[bj][0][1]); w.y = cvt_pk_bf16(v[bj][0][2], v[bj][0][3]); w.z = cvt_pk_bf16(v[bj][1][0], v[bj][1][1]); w.w = cvt_pk_bf16(v[bj][1][2], v[bj][1][3]);
                            *(u32x4*)(rowp + col) = w; } } }
        }
    }
};
template <bool RESF, bool OUTF, bool SCALE = false> struct EpiRes {
    static constexpr bool PERM = true, AFTER_DRAIN = false;
    const float* resf; bf16_t* xb; float* outf; float* ssq; const float* ssq_in;
    __device__ __forceinline__ void operator()(const f32x4 (&acc)[2][2][4][2], const Unit& u, int wr, int wc, int fr, int fq) const {
        const int row0 = u.pm * BM + wr * 64 + fr; const int col0 = u.pn * BM + wc * 32 + 8 * fq;
        constexpr int CH = RESF ? 2 : 4;
        float ssum[8];
#pragma unroll
        for (int rg = 0; rg < 8; ++rg) ssum[rg] = 0.f;
#pragma unroll
        for (int ai = 0; ai < 2; ++ai)
#pragma unroll
            for (int m0 = 0; m0 < 4; m0 += CH) {
                f32x4 rf[CH][2][2]; u32x4 rb[CH][2]; float sqi[CH];
#pragma unroll
                for (int mm = 0; mm < CH; ++mm) sqi[mm] = SCALE ? ssq_in[row0 + ai * HALF + (m0 + mm) * 16] : 0.f;
#pragma unroll
                for (int mm = 0; mm < CH; ++mm)
#pragma unroll
                    for (int bj = 0; bj < 2; ++bj) { const size_t off = (size_t)(row0 + ai * HALF + (m0 + mm) * 16) * 1024 + col0 + bj * HALF;
                        if (RESF) { rf[mm][bj][0] = *(const f32x4*)(resf + off); rf[mm][bj][1] = *(const f32x4*)(resf + off + 4); } else rb[mm][bj] = *(const u32x4*)(xb + off); }
#pragma unroll
                for (int mm = 0; mm < CH; ++mm) { const int m = m0 + mm; const int row = row0 + ai * HALF + m * 16; float s = 0.f;
#pragma unroll
                    for (int bj = 0; bj < 2; ++bj) { const size_t off = (size_t)row * 1024 + col0 + bj * HALF;
                        f32x4 r0, r1;
                        if (RESF) { r0 = rf[mm][bj][0]; r1 = rf[mm][bj][1]; }
                        else { const u32x4 rw = rb[mm][bj];
                            r0 = (f32x4){__uint_as_float(rw.x << 16), __uint_as_float(rw.x & 0xffff0000u), __uint_as_float(rw.y << 16), __uint_as_float(rw.y & 0xffff0000u)};
                            r1 = (f32x4){__uint_as_float(rw.z << 16), __uint_as_float(rw.z & 0xffff0000u), __uint_as_float(rw.w << 16), __uint_as_float(rw.w & 0xffff0000u)}; }
                        const float sc2 = SCALE ? 1.0f / (sqi[mm] * (1.0f / 1024.0f) + 1e-6f) : 1.0f;
                        const f32x4 o0 = r0 + acc[ai][bj][m][0] * sc2, o1 = r1 + acc[ai][bj][m][1] * sc2;
                        if (OUTF) { *(f32x4*)(outf + off) = o0; *(f32x4*)(outf + off + 4) = o1; }
                        else { u32x4 w; w.x = cvt_pk_bf16(o0[0], o0[1]); w.y = cvt_pk_bf16(o0[2], o0[3]); w.z = cvt_pk_bf16(o1[0], o1[1]); w.w = cvt_pk_bf16(o1[2], o1[3]); *(u32x4*)(xb + off) = w;
                            s += (o0[0] * o0[0] + o0[1] * o0[1]) + (o0[2] * o0[2] + o0[3] * o0[3]) + (o1[0] * o1[0] + o1[1] * o1[1]) + (o1[2] * o1[2] + o1[3] * o1[3]); } }
                    if (!OUTF) { s += __shfl_xor(s, 16); s += __shfl_xor(s, 32); ssum[ai * 4 + m] = s; } }
            }
        if (!OUTF && fq == 0) {
#pragma unroll
            for (int rg = 0; rg < 8; ++rg) atomicAdd(ssq + row0 + (rg >> 2) * HALF + (rg & 3) * 16, ssum[rg]);
        }
    }
};
template <class Epi, class Sched, bool ALIGN_EPI = false, bool SP2 = false>
__device__ __forceinline__ void gemm_phase(PG8_LAS unsigned char* lds, const Gemm g, const Sched& S, const Epi& E) {
    const int tid = threadIdx.x, wid = __builtin_amdgcn_readfirstlane(tid >> 6), lane = tid & 63, wr = wid >> 2, wc = wid & 3, fr = lane & 15, fq = lane >> 4;
    const int K = g.K, nt = K / BK;
    unsigned voffA[2], voffB[2];
#pragma unroll
    for (int i = 0; i < 2; ++i) { int R, C; stage_rc(tid * 16 + i * 8192, R, C); const int Rb = Epi::PERM ? ((R & ~31) + perm32(R & 31)) : R;
        voffA[i] = (unsigned)(R * K + C) * 2u; voffB[i] = (unsigned)(Rb * K + C) * 2u; }
    const size_t kstep = (size_t)(BK * 2);
    const size_t hstep = (size_t)HALF * K * 2;
    const size_t tstep = 2 * hstep;
    const unsigned ldsw = (unsigned)wid * 1024u;
    const int aoff = lds_byte(wr * 64 + fr, fq * 8), boff = lds_byte(wc * 32 + fr, fq * 8);
#define PG8_SA(b, h) (((b) * 2 + (h)) * HTB)
#define PG8_SB(b, h) ((4 + (b) * 2 + (h)) * HTB)
#define PG8_STAGE(bufoff, gbase, voff) do { _Pragma("unroll") for (int _i = 0; _i < 2; ++_i) \
        __builtin_amdgcn_global_load_lds((const unsigned*)((const char*)(gbase) + (voff)[_i]), (PG8_LAS unsigned*)(lds + (bufoff) + ldsw + _i * 8192), 16, 0, 0); } while (0)
#define PG8_LDA(dst, b, h) do { _Pragma("unroll") for (int m = 0; m < 4; ++m) _Pragma("unroll") for (int k = 0; k < 2; ++k) dst[m][k] = *(const PG8_LAS bf16x8*)(lds + PG8_SA(b, h) + aoff + m * 2048 + k * 1024); } while (0)
#define PG8_LDB(dst, b, h) do { _Pragma("unroll") for (int n = 0; n < 2; ++n) _Pragma("unroll") for (int k = 0; k < 2; ++k) dst[n][k] = *(const PG8_LAS bf16x8*)(lds + PG8_SB(b, h) + boff + n * 2048 + k * 1024); } while (0)
#define PG8_MMA(ai, bj, At, Bt) do { __builtin_amdgcn_s_setprio(1); _Pragma("unroll") for (int m = 0; m < 4; ++m) _Pragma("unroll") for (int n = 0; n < 2; ++n) _Pragma("unroll") for (int k = 0; k < 2; ++k) \
        acc[ai][bj][m][n] = __builtin_amdgcn_mfma_f32_16x16x32_bf16(Bt[n][k], At[m][k], acc[ai][bj][m][n], 0, 0, 0); __builtin_amdgcn_s_setprio(0); } while (0)
#define PG8_WAIT_V(n) asm volatile("s_waitcnt vmcnt(" #n ")" ::: "memory")
#define PG8_WAIT_L(n) asm volatile("s_waitcnt lgkmcnt(" #n ")" ::: "memory")
#define PG8_BAR __builtin_amdgcn_s_barrier()
#define PG8_SCHED __builtin_amdgcn_sched_barrier(0)
    Unit cur, nxt; int ui = 0;
    if (!S.next(0, cur)) return;
    f32x4 acc[2][2][4][2];
#pragma unroll
    for (int a = 0; a < 2; ++a)
#pragma unroll
        for (int b = 0; b < 2; ++b)
#pragma unroll
            for (int m = 0; m < 4; ++m)
#pragma unroll
                for (int n = 0; n < 2; ++n) acc[a][b][m][n] = (f32x4){0.f, 0.f, 0.f, 0.f};
    bf16x8 At[4][2], B0[2][2], B1[2][2];
    const char* cA = (const char*)g.A + (size_t)cur.pm * tstep; const char* cB = (const char*)g.Bt + (size_t)cur.pn * tstep;
    S.a_ready(cur);
    if constexpr (SP2) {
        PG8_STAGE(PG8_SB(0, 0), cB, voffB); PG8_STAGE(PG8_SB(0, 1), cB + hstep, voffB); PG8_STAGE(PG8_SA(0, 0), cA, voffA); PG8_STAGE(PG8_SA(0, 1), cA + hstep, voffA);
        if (wr == 1) PG8_BAR;
        PG8_WAIT_V(2); PG8_BAR;
        PG8_STAGE(PG8_SB(1, 0), cB + kstep, voffB); PG8_STAGE(PG8_SA(1, 0), cA + kstep, voffA); PG8_STAGE(PG8_SB(1, 1), cB + hstep + kstep, voffB);
        PG8_WAIT_V(6); PG8_BAR;
    } else {
        PG8_STAGE(PG8_SB(0, 0), cB, voffB); PG8_STAGE(PG8_SA(0, 0), cA, voffA); PG8_STAGE(PG8_SB(0, 1), cB + hstep, voffB); PG8_STAGE(PG8_SA(0, 1), cA + hstep, voffA);
        if (wr == 1) PG8_BAR;
        PG8_WAIT_V(4); PG8_BAR;
        PG8_STAGE(PG8_SB(1, 0), cB + kstep, voffB); PG8_STAGE(PG8_SA(1, 0), cA + kstep, voffA); PG8_STAGE(PG8_SB(1, 1), cB + hstep + kstep, voffB);
        PG8_WAIT_V(6); PG8_BAR;
    }
    for (;;) {
        const bool has_next = S.next(ui + 1, nxt);
        const char* nA = has_next ? (const char*)g.A + (size_t)nxt.pm * tstep : cA; const char* nB = has_next ? (const char*)g.Bt + (size_t)nxt.pn * tstep : cB;
        for (int t = 0; t < nt; t += 2) {
            const bool last = (t == nt - 2);
            const char* a1 = cA + (size_t)(t + 1) * kstep;
            const char* a2 = last ? nA : cA + (size_t)(t + 2) * kstep; const char* b2 = last ? nB : cB + (size_t)(t + 2) * kstep;
            const char* a3 = a2 + kstep; const char* b3 = b2 + kstep;
            if (last && has_next) S.a_ready(nxt);
            if constexpr (SP2) {
            PG8_LDB(B0, 0, 0); PG8_LDB(B1, 0, 1); PG8_SCHED; PG8_LDA(At, 0, 0); PG8_STAGE(PG8_SA(1, 1), a1 + hstep, voffA);
            PG8_WAIT_V(8); PG8_WAIT_L(0); PG8_BAR; PG8_MMA(0, 0, At, B0); PG8_MMA(0, 1, At, B1); PG8_BAR; PG8_SCHED;
            PG8_LDA(At, 0, 1); PG8_STAGE(PG8_SB(0, 0), b2, voffB); PG8_STAGE(PG8_SB(0, 1), b2 + hstep, voffB); PG8_STAGE(PG8_SA(0, 0), a2, voffA);
            PG8_WAIT_V(8); PG8_WAIT_L(0); PG8_BAR; PG8_MMA(1, 0, At, B0); PG8_MMA(1, 1, At, B1); PG8_BAR; PG8_SCHED;
            PG8_LDB(B0, 1, 0); PG8_LDB(B1, 1, 1); PG8_SCHED; PG8_LDA(At, 1, 0); PG8_STAGE(PG8_SA(0, 1), a2 + hstep, voffA);
            PG8_WAIT_V(8); PG8_WAIT_L(0); PG8_BAR; PG8_MMA(0, 0, At, B0); PG8_MMA(0, 1, At, B1); PG8_BAR; PG8_SCHED;
            PG8_LDA(At, 1, 1); PG8_STAGE(PG8_SB(1, 0), b3, voffB); PG8_STAGE(PG8_SB(1, 1), b3 + hstep, voffB); PG8_STAGE(PG8_SA(1, 0), a3, voffA);
            PG8_WAIT_V(8); PG8_WAIT_L(0); PG8_BAR; PG8_MMA(1, 0, At, B0); PG8_MMA(1, 1, At, B1); PG8_BAR; PG8_SCHED;
            } else {
            PG8_LDB(B0, 0, 0); PG8_SCHED; PG8_LDA(At, 0, 0); PG8_STAGE(PG8_SA(1, 1), a1 + hstep, voffA);
            PG8_WAIT_L(8); PG8_BAR; PG8_WAIT_L(0); PG8_MMA(0, 0, At, B0); PG8_BAR; PG8_SCHED;
            PG8_LDB(B1, 0, 1); PG8_STAGE(PG8_SB(0, 0), b2, voffB);
            PG8_BAR; PG8_WAIT_L(0); PG8_MMA(0, 1, At, B1); PG8_BAR;
            PG8_LDA(At, 0, 1); PG8_STAGE(PG8_SA(0, 0), a2, voffA);
            PG8_BAR; PG8_WAIT_L(0); PG8_MMA(1, 0, At, B0); PG8_BAR; PG8_SCHED;
            PG8_STAGE(PG8_SB(0, 1), b2 + hstep, voffB);
            PG8_WAIT_V(6); PG8_BAR; PG8_MMA(1, 1, At, B1); PG8_BAR;
            PG8_LDB(B0, 1, 0); PG8_SCHED; PG8_LDA(At, 1, 0); PG8_STAGE(PG8_SA(0, 1), a2 + hstep, voffA);
            PG8_WAIT_L(8); PG8_BAR; PG8_WAIT_L(0); PG8_MMA(0, 0, At, B0); PG8_BAR; PG8_SCHED;
            PG8_LDB(B1, 1, 1); PG8_STAGE(PG8_SB(1, 0), b3, voffB);
            PG8_BAR; PG8_WAIT_L(0); PG8_MMA(0, 1, At, B1); PG8_BAR;
            PG8_LDA(At, 1, 1); PG8_STAGE(PG8_SA(1, 0), a3, voffA);
            PG8_BAR; PG8_WAIT_L(0); PG8_MMA(1, 0, At, B0); PG8_BAR; PG8_SCHED;
            PG8_STAGE(PG8_SB(1, 1), b3 + hstep, voffB);
            PG8_WAIT_V(6); PG8_BAR; PG8_MMA(1, 1, At, B1); PG8_BAR;
            }
        }
        if constexpr (ALIGN_EPI) { if (wr == 0) PG8_BAR; }
        if constexpr (!Epi::AFTER_DRAIN) { E(acc, cur, wr, wc, fr, fq); S.done(cur); }
        if (!has_next) break;
#pragma unroll
        for (int a = 0; a < 2; ++a)
#pragma unroll
            for (int b = 0; b < 2; ++b)
#pragma unroll
                for (int m = 0; m < 4; ++m)
#pragma unroll
                    for (int n = 0; n < 2; ++n) acc[a][b][m][n] = (f32x4){0.f, 0.f, 0.f, 0.f};
        cur = nxt; cA = nA; cB = nB; ++ui;
        if constexpr (ALIGN_EPI) { if (wr == 1) PG8_BAR; }
    }
    PG8_WAIT_V(0);
    if constexpr (!ALIGN_EPI) { if (wr == 0) PG8_BAR; }
    PG8_BAR;
    if constexpr (Epi::AFTER_DRAIN) { E.fused(acc, cur, wr, wc, fr, fq, lds, wid, lane); S.done(cur); }
#undef PG8_SA
#undef PG8_SB
#undef PG8_STAGE
#undef PG8_LDA
#undef PG8_LDB
#undef PG8_MMA
#undef PG8_WAIT_V
#undef PG8_WAIT_L
#undef PG8_BAR
#undef PG8_SCHED
}
}
#ifndef ONE_LAUNCH
#define ONE_LAUNCH 1
#endif
#define LAS __attribute__((address_space(3)))
typedef unsigned short bf16_t;
typedef short bf16x8 __attribute__((ext_vector_type(8)));
typedef short s16x4 __attribute__((ext_vector_type(4)));
typedef float f32x4 __attribute__((ext_vector_type(4)));
typedef unsigned u32x4 __attribute__((ext_vector_type(4)));
typedef unsigned u32x2 __attribute__((ext_vector_type(2)));

constexpr int BATCH = 8, T = 4096, D = 1024, M = BATCH * T, FF = 4096;
constexpr int NPROJ = 4112, NPROJ_PAD = 4352, NQKV = 3072, NMIX = 2048;
constexpr int C_Z = 0, C_XBC = 1024, C_Q = 2560, C_K = 3584, C_V = 3840;
constexpr float EPS = 1e-6f;
constexpr float LOG2E = 1.4426950408889634f;
constexpr size_t MiB = 1u << 20;
constexpr size_t WS_SSQ = 0;
constexpr size_t WS_CD = 512 * 1024;
constexpr size_t WS_DT = 1 * MiB;
constexpr size_t WS_WIN = 3 * MiB, WS_WOE = 12 * MiB, WS_W1 = 16 * MiB  , WS_W2 = 32 * MiB  , WS_WQKV = 48 * MiB, WS_WOO = 54 * MiB;
constexpr size_t WS_XB = 56 * MiB;
constexpr size_t WS_PROJ = 120 * MiB;
constexpr size_t WS_Y = 377 * MiB;
constexpr size_t WS_END = 505 * MiB;
constexpr int LDS_BYTES = 147456;
constexpr int NPHASE = 13;

struct Params { const float* in[26]; float* out; unsigned char* ws; int ph_lo, ph_hi; };

__device__ __forceinline__ float bflo(unsigned u) { return __uint_as_float(u << 16); }
__device__ __forceinline__ float bfhi(unsigned u) { return __uint_as_float(u & 0xffff0000u); }
__device__ __forceinline__ float bf1(bf16_t v) { return __uint_as_float(((unsigned)v) << 16); }
typedef float f32x2_t __attribute__((ext_vector_type(2)));
typedef __bf16 bf16x2_t __attribute__((ext_vector_type(2)));
__device__ __forceinline__ unsigned pk2(float lo, float hi) { f32x2_t v = {lo, hi}; bf16x2_t b = __builtin_convertvector(v, bf16x2_t); return __builtin_bit_cast(unsigned, b); }
__device__ __forceinline__ void unpack8(const u32x4 r, float (&v)[8]) { v[0] = bflo(r.x); v[1] = bfhi(r.x); v[2] = bflo(r.y); v[3] = bfhi(r.y); v[4] = bflo(r.z); v[5] = bfhi(r.z); v[6] = bflo(r.w); v[7] = bfhi(r.w); }
__device__ __forceinline__ u32x4 pack8(const float (&v)[8]) { u32x4 r; r.x = pk2(v[0], v[1]); r.y = pk2(v[2], v[3]); r.z = pk2(v[4], v[5]); r.w = pk2(v[6], v[7]); return r; }
__device__ __forceinline__ f32x4 mfma16(bf16x8 a, bf16x8 b, f32x4 c) { return __builtin_amdgcn_mfma_f32_16x16x32_bf16(a, b, c, 0, 0, 0); }
__device__ __forceinline__ bf16x8 as_frag(u32x4 r) { return __builtin_bit_cast(bf16x8, r); }
__device__ __forceinline__ float siluf(float v) { return v * __builtin_amdgcn_rcpf(1.0f + __builtin_amdgcn_exp2f(-1.4426950408889634f * v)); }
typedef short v4i16_t __attribute__((ext_vector_type(4)));
__device__ __forceinline__ u32x2 lds_tr(const LAS bf16_t* p) { return __builtin_bit_cast(u32x2, __builtin_amdgcn_ds_read_tr16_b64_v4i16((LAS v4i16_t*)p)); }

__device__ __forceinline__ int map_cols(int mode, int n0, int& nvalid) {
    if (mode == 0) { nvalid = 32; return n0; }
    const int tile = n0 >> 8, within = n0 & 255, bj = within >> 7, wc = (within & 127) >> 5;
    const int cl = tile * 256 + 64 * wc + 32 * bj;
    if (mode == 2) { nvalid = 32; return cl; }
    if (cl < 2560) { nvalid = 32; return cl; }
    if (cl < 4096) { nvalid = 32; return cl + 16; }
    if (cl == 4096) { nvalid = 16; return 2560; }
    nvalid = 0; return 0;
}
__device__ __forceinline__ void p0_transpose_item(const float* W, int K, int Nsrc, int Nphys, int mode, bf16_t* WT, const float* ksc, LAS float* scr, int item, int lane) {
    const int nblk = Nphys / 32, kb = item / nblk, nb = item % nblk, k0 = 64 * kb, n0 = 32 * nb;
    int nvalid; const int ns0 = map_cols(mode, n0, nvalid);
    const int kk8 = lane >> 3, n4 = (lane & 7) * 4;
    const bool ok = n4 < nvalid;
    float kscv[8]; f32x4 wv[8];
#pragma unroll
    for (int i = 0; i < 8; ++i) kscv[i] = ksc ? ksc[k0 + 8 * i + kk8] : 1.0f;
#pragma unroll
    for (int i = 0; i < 8; ++i) { const int kk = 8 * i + kk8; wv[i] = ok ? *(const f32x4*)(W + (size_t)(k0 + kk) * Nsrc + ns0 + n4) : (f32x4){0.f, 0.f, 0.f, 0.f}; }
#pragma unroll
    for (int i = 0; i < 8; ++i) { const int kk = 8 * i + kk8; const f32x4 v = wv[i] * kscv[i];
        LAS float* d = scr + kk * 33 + n4; d[0] = v[0]; d[1] = v[1]; d[2] = v[2]; d[3] = v[3]; }
    asm volatile("s_waitcnt lgkmcnt(0)" ::: "memory");
    const int c = lane & 7;
#pragma unroll
    for (int j = 0; j < 4; ++j) { const int n = (lane >> 3) + 8 * j; const LAS float* sp = scr + (8 * c) * 33 + n;
        u32x4 o; o.x = pk2(sp[0 * 33], sp[1 * 33]); o.y = pk2(sp[2 * 33], sp[3 * 33]); o.z = pk2(sp[4 * 33], sp[5 * 33]); o.w = pk2(sp[6 * 33], sp[7 * 33]);
        *(u32x4*)(WT + (size_t)(n0 + n) * K + k0 + 8 * c) = o; }
    asm volatile("s_waitcnt lgkmcnt(0)" ::: "memory");
}
__device__ __forceinline__ void p0_prologue(const Params& P, LAS unsigned char* lds, int G) {
    const int tid = threadIdx.x, lane = tid & 63, wave = tid >> 6;
    LAS float* scr = (LAS float*)(lds + wave * 16384);
    const int gw = blockIdx.x * 8 + wave, NGW = G * 8;
    unsigned char* ws = P.ws;
    constexpr int I0 = 16 * 136, I1 = 32 * 32, I2 = 16 * 128, I3 = I2, I4 = 64 * 32, I5 = I4, I6 = 16 * 96, I7 = 16 * 32;
    constexpr int NIT = I0 + I1 + I2 + I3 + I4 + I5 + I6 + I7;
    for (int it = gw; it < NIT; it += NGW) {
        int r = it;
        if (r < I0) { p0_transpose_item(P.in[2], D, NPROJ, NPROJ_PAD, 1, (bf16_t*)(ws + WS_WIN), P.in[1], scr, r, lane); continue; } r -= I0;
        if (r < I1) { p0_transpose_item(P.in[12], NMIX, D, D, 0, (bf16_t*)(ws + WS_WOE), nullptr, scr, r, lane); continue; } r -= I1;
        if (r < I2) { p0_transpose_item(P.in[24], D, FF, FF, 0, (bf16_t*)(ws + WS_W1), P.in[23], scr, r, lane); continue; } r -= I2;
        if (r < I3) { p0_transpose_item(P.in[24] + (size_t)D * FF, D, FF, FF, 0, (bf16_t*)(ws + WS_W1 + 8 * MiB), P.in[23] + D, scr, r, lane); continue; } r -= I3;
        if (r < I4) { p0_transpose_item(P.in[25], FF, D, D, 0, (bf16_t*)(ws + WS_W2), nullptr, scr, r, lane); continue; } r -= I4;
        if (r < I5) { p0_transpose_item(P.in[25] + (size_t)D * FF, FF, D, D, 0, (bf16_t*)(ws + WS_W2 + 8 * MiB), nullptr, scr, r, lane); continue; } r -= I5;
        if (r < I6) { p0_transpose_item(P.in[14], D, NQKV, NQKV, 2, (bf16_t*)(ws + WS_WQKV), P.in[13], scr, r, lane); continue; } r -= I6;
        p0_transpose_item(P.in[22], D, D, D, 0, (bf16_t*)(ws + WS_WOO), nullptr, scr, r, lane);
    }
    { float* z = (float*)(ws + WS_SSQ) + M; for (int i = blockIdx.x * 512 + tid; i < 3 * M; i += G * 512) z[i] = 0.f; }
    const float* x = P.in[0]; bf16_t* XB = (bf16_t*)(ws + WS_XB); float* ssq0 = (float*)(ws + WS_SSQ); float* dtb = (float*)(ws + WS_DT);
    constexpr int WDP = 1032;
    LAS bf16_t* Wd = (LAS bf16_t*)lds;
    __syncthreads();
    { const float* Wsrc = P.in[2]; const float* nw = P.in[1];
#pragma unroll
      for (int q = 0; q < 2; ++q) { const int k = 2 * tid + q; const float sc = nw[k]; const f32x4* wr = (const f32x4*)(Wsrc + (size_t)k * NPROJ + 2560);
          const f32x4 w0 = wr[0] * sc, w1 = wr[1] * sc, w2 = wr[2] * sc, w3 = wr[3] * sc;
          const float wv[16] = {w0[0], w0[1], w0[2], w0[3], w1[0], w1[1], w1[2], w1[3], w2[0], w2[1], w2[2], w2[3], w3[0], w3[1], w3[2], w3[3]};
#pragma unroll
          for (int h = 0; h < 16; ++h) Wd[h * WDP + k] = (bf16_t)(pk2(wv[h], wv[h]) & 0xffffu); } }
    __syncthreads();
    { const int g = lane >> 4, i = lane & 15;
      for (int grp = gw; grp < M / 16; grp += NGW) {
        const int row = 16 * grp + i; const float* xr = x + (size_t)row * D + 8 * g; bf16_t* xo = XB + (size_t)row * D + 8 * g;
        f32x4 cacc = (f32x4){0.f, 0.f, 0.f, 0.f}; float ss = 0.f;
        f32x4 xa[2][4], xb2[2][4];
#pragma unroll
        for (int q = 0; q < 4; ++q) { xa[0][q] = *(const f32x4*)(xr + 32 * q); xb2[0][q] = *(const f32x4*)(xr + 32 * q + 4); }
#pragma unroll
        for (int kb = 0; kb < 8; ++kb) {
            if (kb < 7) {
#pragma unroll
                for (int q = 0; q < 4; ++q) { xa[(kb + 1) & 1][q] = *(const f32x4*)(xr + 32 * (4 * (kb + 1) + q)); xb2[(kb + 1) & 1][q] = *(const f32x4*)(xr + 32 * (4 * (kb + 1) + q) + 4); }
            }
#pragma unroll
            for (int q = 0; q < 4; ++q) { const int ks = 4 * kb + q; const f32x4 a = xa[kb & 1][q], c = xb2[kb & 1][q];
                ss += (a[0] * a[0] + a[1] * a[1]) + (a[2] * a[2] + a[3] * a[3]) + (c[0] * c[0] + c[1] * c[1]) + (c[2] * c[2] + c[3] * c[3]);
                u32x4 pk; pk.x = pk2(a[0], a[1]); pk.y = pk2(a[2], a[3]); pk.z = pk2(c[0], c[1]); pk.w = pk2(c[2], c[3]);
                *(u32x4*)(xo + 32 * ks) = pk;
                const bf16x8 wf = *(const LAS bf16x8*)(Wd + i * WDP + 32 * ks + 8 * g);
                cacc = mfma16(as_frag(pk), wf, cacc); }
        }
        ss += __shfl_xor(ss, 16); ss += __shfl_xor(ss, 32);
        if (g == 0) ssq0[row] = ss;
#pragma unroll
        for (int r = 0; r < 4; ++r) { const float sr = __shfl(ss, 4 * g + r); dtb[(size_t)(16 * grp + 4 * g + r) * 16 + i] = cacc[r] * rsqrtf(sr * (1.0f / 1024.0f) + EPS); }
      } }
}

template <int NQK, int NK, int DV>
__device__ __forceinline__ void attn_tile(const LAS unsigned char* buf, const bf16x8 (&qf)[NQK][2], f32x4 (&acc)[NQK][DV / 16], float (&lrun)[NQK],
                                          const float (&slope2v)[NQK], int qrel, int j, bool diag, int g, int i) {
    constexpr int KP = 72, VP = DV + 16, NDT = DV / 16, KBYTES = NK * 64 * KP * 2;
    const LAS bf16_t* Ks = (const LAS bf16_t*)buf; const LAS bf16_t* Vn = (const LAS bf16_t*)(buf + KBYTES);
    constexpr int HG = NQK < 2 ? NQK : 2;
#pragma unroll
    for (int a0 = 0; a0 < NQK; a0 += HG) {
    bf16x8 pf[HG][2];
#pragma unroll
    for (int aa = 0; aa < HG; ++aa) {
        const int a = a0 + aa;
        f32x4 s[4]; const float slope2 = slope2v[a]; const int ka = (NK == NQK) ? a : 0;
        float oz = 0.f; asm volatile("" : "+v"(oz));
        f32x4 binit[4];
        if (!diag) {
            float bb = slope2 * (float)(64 * j - qrel + 4 * g) + oz; const float s12 = 12.0f * slope2;
#pragma unroll
            for (int kt = 0; kt < 4; ++kt) {
#pragma unroll
                for (int r = 0; r < 4; ++r) { binit[kt][r] = bb; bb += slope2; }
                bb += s12; }
        } else {
            float dd = (float)(qrel - 64 * j - 4 * g) + oz;
#pragma unroll
            for (int kt = 0; kt < 4; ++kt) {
#pragma unroll
                for (int r = 0; r < 4; ++r) { binit[kt][r] = -slope2 * fabsf(dd); dd -= 1.0f; }
                dd -= 12.0f; }
        }
#pragma unroll
        for (int kt = 0; kt < 4; ++kt) { f32x4 c = binit[kt];
#pragma unroll
            for (int ks = 0; ks < 2; ++ks) { const bf16x8 kf = *(const LAS bf16x8*)(Ks + (ka * 64 + 16 * kt + i) * KP + 32 * ks + 8 * g); c = mfma16(kf, qf[a][ks], c); }
            s[kt] = c; }
        float ls = 0.f;
#pragma unroll
        for (int kt = 0; kt < 4; ++kt)
#pragma unroll
            for (int r = 0; r < 4; ++r) { s[kt][r] = __builtin_amdgcn_exp2f(s[kt][r]); ls += s[kt][r]; }
        lrun[a] += ls;
#pragma unroll
        for (int s2 = 0; s2 < 2; ++s2) { u32x4 p; p.x = pk2(s[2 * s2][0], s[2 * s2][1]); p.y = pk2(s[2 * s2][2], s[2 * s2][3]); p.z = pk2(s[2 * s2 + 1][0], s[2 * s2 + 1][1]); p.w = pk2(s[2 * s2 + 1][2], s[2 * s2 + 1][3]); pf[aa][s2] = as_frag(p); }
    }
#pragma unroll
    for (int dt = 0; dt < NDT; ++dt)
#pragma unroll
        for (int s2 = 0; s2 < 2; ++s2) {
            const LAS bf16_t* vp = Vn + (32 * s2 + 4 * g + (i >> 2)) * VP + 16 * dt + 4 * (i & 3);
            const u32x2 lo = lds_tr(vp), hi = lds_tr(vp + 16 * VP);
            u32x4 vv; vv.x = lo.x; vv.y = lo.y; vv.z = hi.x; vv.w = hi.y; const bf16x8 vf = as_frag(vv);
#pragma unroll
            for (int aa = 0; aa < HG; ++aa) acc[a0 + aa][dt] = mfma16(vf, pf[aa][s2], acc[a0 + aa][dt]);
        }
    }
}
template <int NQK, int NK, int DV>
__device__ __forceinline__ void attn_unit(LAS unsigned char* lds, const bf16_t* Qg, const bf16_t* Kg, const bf16_t* Vg, int pitch,
                                          int q0, int jlo, int jhi, int wlo, int whi, const float (&slope2v)[NQK], const float (&linit)[NQK],
                                          bf16_t* Og, int opitch, float lam, const float* subw, float oscale) {
    constexpr int KP = 72, VP = DV + 16, NDT = DV / 16, NVP = DV / 64;
    constexpr int KBYTES = NK * 64 * KP * 2, BUFBYTES = KBYTES + 64 * VP * 2;
    const int tid = threadIdx.x, lane = tid & 63, w = __builtin_amdgcn_readfirstlane(tid >> 6), g = lane >> 4, i = lane & 15;
    bf16x8 qf[NQK][2];
    {
        const bf16_t* qrow = Qg + (size_t)(16 * w + i) * pitch;
#pragma unroll
        for (int a = 0; a < NQK; ++a) { u32x4 r0 = *(const u32x4*)(qrow + a * 64 + 8 * g), r1 = *(const u32x4*)(qrow + a * 64 + 32 + 8 * g);
            asm volatile("" : "+v"(r0), "+v"(r1));
            qf[a][0] = as_frag(r0); qf[a][1] = as_frag(r1); }
    }
    const int krow = tid >> 3, kseg = tid & 7;
    u32x4 kA[NK], vA[NVP], kB[NK], vB[NVP];
    f32x4 acc[NQK][NDT];
    float lrun[NQK];
#pragma unroll
    for (int a = 0; a < NQK; ++a) { lrun[a] = (g == 0) ? linit[a] : 0.f;
#pragma unroll
        for (int dt = 0; dt < NDT; ++dt) acc[a][dt] = (f32x4){0.f, 0.f, 0.f, 0.f}; }
    const int qrel = q0 + 16 * w + i;
#define ATT_PREFETCH(KR, VR, jj) do { _Pragma("unroll") for (int a = 0; a < NK; ++a) KR[a] = *(const u32x4*)(Kg + (size_t)((jj) * 64 + krow) * pitch + a * 64 + 8 * kseg); \
        _Pragma("unroll") for (int pc = 0; pc < NVP; ++pc) { const int idx = tid + 512 * pc, key = idx / (DV / 8), seg = idx % (DV / 8); VR[pc] = *(const u32x4*)(Vg + (size_t)((jj) * 64 + key) * pitch + 8 * seg); } } while (0)
#define ATT_STAGE(KR, VR, bb) do { LAS bf16_t* Ks_ = (LAS bf16_t*)(lds + (bb) * BUFBYTES); LAS bf16_t* Vn_ = (LAS bf16_t*)(lds + (bb) * BUFBYTES + KBYTES); \
        _Pragma("unroll") for (int a = 0; a < NK; ++a) *(LAS u32x4*)(Ks_ + (a * 64 + krow) * KP + 8 * kseg) = KR[a]; \
        _Pragma("unroll") for (int pc = 0; pc < NVP; ++pc) { const int idx = tid + 512 * pc, key = idx / (DV / 8), seg = idx % (DV / 8); *(LAS u32x4*)(Vn_ + key * VP + 8 * seg) = VR[pc]; } } while (0)
    ATT_PREFETCH(kA, vA, jlo);
    ATT_STAGE(kA, vA, 0);
    if (jlo + 1 <= jhi) ATT_PREFETCH(kA, vA, jlo + 1);
    if (jlo + 2 <= jhi) ATT_PREFETCH(kB, vB, jlo + 2);
    for (int j = jlo; j <= jhi; j += 2) {
        __syncthreads();
        if (j + 1 <= jhi) { ATT_STAGE(kA, vA, 1); if (j + 3 <= jhi) ATT_PREFETCH(kA, vA, j + 3); }
        if (j >= wlo && j <= whi) attn_tile<NQK, NK, DV>(lds, qf, acc, lrun, slope2v, qrel, j, j == whi, g, i);
        if (j + 1 <= jhi) {
            __syncthreads();
            if (j + 2 <= jhi) { ATT_STAGE(kB, vB, 0); if (j + 4 <= jhi) ATT_PREFETCH(kB, vB, j + 4); }
            if (j + 1 >= wlo && j + 1 <= whi) attn_tile<NQK, NK, DV>(lds + BUFBYTES, qf, acc, lrun, slope2v, qrel, j + 1, j + 1 == whi, g, i);
        }
    }
#undef ATT_PREFETCH
#undef ATT_STAGE
#pragma unroll
    for (int a = 0; a < NQK; ++a) { lrun[a] += __shfl_xor(lrun[a], 16); lrun[a] += __shfl_xor(lrun[a], 32); }
    bf16_t* orow = Og + (size_t)(16 * w + i) * opitch;
    if constexpr (NK == 2) {
        const float i0 = 1.0f / lrun[0], i1 = lam / lrun[1];
        f32x4 o[NDT]; float ss = 0.f;
#pragma unroll
        for (int dt = 0; dt < NDT; ++dt) { o[dt] = acc[0][dt] * i0 - acc[1][dt] * i1; ss += (o[dt][0] * o[dt][0] + o[dt][1] * o[dt][1]) + (o[dt][2] * o[dt][2] + o[dt][3] * o[dt][3]); }
        ss += __shfl_xor(ss, 16); ss += __shfl_xor(ss, 32);
        const float rs = rsqrtf(ss * (1.0f / (float)DV) + EPS) * oscale;
        f32x4 swv[NDT];
#pragma unroll
        for (int dt = 0; dt < NDT; ++dt) swv[dt] = *(const f32x4*)(subw + 16 * dt + 4 * g);
#pragma unroll
        for (int dt = 0; dt < NDT; ++dt) { const f32x4 sw = swv[dt]; const f32x4 v = o[dt] * rs * sw;
            u32x2 pkd; pkd.x = pk2(v[0], v[1]); pkd.y = pk2(v[2], v[3]); *(u32x2*)(orow + 16 * dt + 4 * g) = pkd; }
    } else {
#pragma unroll
        for (int a = 0; a < NQK; ++a) { const float i0 = 1.0f / lrun[a];
#pragma unroll
            for (int dt = 0; dt < NDT; ++dt) { const f32x4 v = acc[a][dt] * i0; u32x2 pkd; pkd.x = pk2(v[0], v[1]); pkd.y = pk2(v[2], v[3]); *(u32x2*)(orow + a * DV + 16 * dt + 4 * g) = pkd; } }
    }
}
template <bool TRANS>
__device__ __forceinline__ void conv_item(const bf16_t* xbc, int tg0, int c0, const float* cw, const float* cb, u32x4 (&out)[8]) {
    float wgt[4][8], bias[8];
#pragma unroll
    for (int e = 0; e < 8; ++e) { bias[e] = cb[c0 + e];
#pragma unroll
        for (int k = 0; k < 4; ++k) wgt[k][e] = cw[k * 1536 + c0 + e]; }
    u32x4 raw[11];
#pragma unroll
    for (int k = 0; k < 11; ++k) { const int t = tg0 - 3 + k; raw[k] = (t >= 0) ? *(const u32x4*)(xbc + (size_t)t * NPROJ + c0) : (u32x4){0u, 0u, 0u, 0u}; }
    float prev[8];
#pragma unroll
    for (int l = 0; l < 8; ++l) {
        float y[8];
#pragma unroll
        for (int e = 0; e < 8; ++e) y[e] = bias[e];
#pragma unroll
        for (int k = 0; k < 4; ++k) { float v[8]; unpack8(raw[l + k], v);
#pragma unroll
            for (int e = 0; e < 8; ++e) y[e] += wgt[k][e] * v[e]; }
#pragma unroll
        for (int e = 0; e < 8; ++e) y[e] = siluf(y[e]);
        if (TRANS) {
            if (l & 1) {
#pragma unroll
                for (int e = 0; e < 8; ++e) out[e][l >> 1] = pk2(prev[e], y[e]);
            } else {
#pragma unroll
                for (int e = 0; e < 8; ++e) prev[e] = y[e];
            }
        } else out[l] = pack8(y);
    }
}
__device__ __forceinline__ float softplusf(float x) { return fmaxf(x, 0.f) + log1pf(__expf(-fabsf(x))); }

__device__ __forceinline__ float ssd_dt_load(const Params& P, int b, int t0, int h, int lane) {
    const float* dtb = (const float*)(P.ws + WS_DT);
    return dtb[(size_t)(b * T + t0 + lane) * 16 + h];
}
__device__ __forceinline__ void ssd_dt(const Params& P, float rawv, int h, int lane, float& dt, float& acum, float& atot) {
    const float raw = rawv + P.in[5][h];
    dt = softplusf(raw);
    const float a = -__expf(P.in[6][h]);
    float x = dt * a;
#pragma unroll
    for (int o = 1; o < 64; o <<= 1) { const float y = __shfl_up(x, o); if (lane >= o) x += y; }
    acum = x; atot = __shfl(x, 63);
}

__device__ __forceinline__ void ssd_pass_a(const Params& P, LAS unsigned char* lds, int unit) {
    const int tid = threadIdx.x, lane = tid & 63, w = __builtin_amdgcn_readfirstlane(tid >> 6), g = lane >> 4, i = lane & 15;
    const int grp = unit & 1, c = (unit >> 1) & 63, b = unit >> 7, t0 = c * 64, h = grp * 8 + w;
    const bf16_t* proj = (const bf16_t*)(P.ws + WS_PROJ);
    const bf16_t* xbc = proj + (size_t)(b * T) * NPROJ + C_XBC;
    LAS bf16_t* XT = (LAS bf16_t*)lds; LAS bf16_t* BT = XT + 512 * 72; LAS float* WST = (LAS float*)(lds + 92160);
    const float dtraw = ssd_dt_load(P, b, t0, h, lane);
    __syncthreads();
    { const int cgi = tid & 63, lseg = tid >> 6; u32x4 o[8]; conv_item<true>(xbc, t0 + 8 * lseg, grp * 512 + 8 * cgi, P.in[3], P.in[4], o);
#pragma unroll
      for (int e = 0; e < 8; ++e) *(LAS u32x4*)(XT + (8 * cgi + e) * 72 + 8 * lseg) = o[e]; }
    if (tid < 128) { const int cgi = tid & 15, lseg = tid >> 4; u32x4 o[8]; conv_item<true>(xbc, t0 + 8 * lseg, 1024 + grp * 128 + 8 * cgi, P.in[3], P.in[4], o);
#pragma unroll
      for (int e = 0; e < 8; ++e) *(LAS u32x4*)(BT + (8 * cgi + e) * 72 + 8 * lseg) = o[e]; }
    { float dt, acum, atot; ssd_dt(P, dtraw, h, lane, dt, acum, atot);
      WST[w * 64 + lane] = dt * __expf(atot - acum);
      if (lane == 0) ((float*)(P.ws + WS_CD))[(b * 64 + c) * 16 + h] = __expf(atot); }
    __syncthreads();
    bf16_t* st = (bf16_t*)P.out + (size_t)((b * 64 + c) * 16 + h) * 8192;
#pragma unroll 1
    for (int pt = 0; pt < 4; ++pt) {
        bf16x8 xf[2];
#pragma unroll
        for (int ks = 0; ks < 2; ++ks) { const u32x4 raw = *(const LAS u32x4*)(XT + (w * 64 + 16 * pt + i) * 72 + 32 * ks + 8 * g); float v[8]; unpack8(raw, v);
            const f32x4 s0 = *(const LAS f32x4*)(WST + w * 64 + 32 * ks + 8 * g), s1 = *(const LAS f32x4*)(WST + w * 64 + 32 * ks + 8 * g + 4);
            v[0] *= s0[0]; v[1] *= s0[1]; v[2] *= s0[2]; v[3] *= s0[3]; v[4] *= s1[0]; v[5] *= s1[1]; v[6] *= s1[2]; v[7] *= s1[3];
            xf[ks] = as_frag(pack8(v)); }
#pragma unroll
        for (int nt = 0; nt < 8; ++nt) { f32x4 cacc = (f32x4){0.f, 0.f, 0.f, 0.f};
#pragma unroll
            for (int ks = 0; ks < 2; ++ks) { const bf16x8 af = *(const LAS bf16x8*)(BT + (16 * nt + i) * 72 + 32 * ks + 8 * g); cacc = mfma16(af, xf[ks], cacc); }
            u32x2 pkd; pkd.x = pk2(cacc[0], cacc[1]); pkd.y = pk2(cacc[2], cacc[3]);
            *(u32x2*)(st + (16 * pt + i) * 128 + 16 * nt + 4 * g) = pkd; }
    }
}

__device__ __forceinline__ void ssd_scan(const Params& P, int G) {
    bf16_t* ST = (bf16_t*)P.out; const float* CD = (const float*)(P.ws + WS_CD);
    for (int v = blockIdx.x * 512 + threadIdx.x; v < BATCH * 16 * 8192 / 8; v += G * 512) {
        const int e = v * 8, off = e & 8191, h = (e >> 13) & 15, b = e >> 17;
        float run[8];
#pragma unroll
        for (int k = 0; k < 8; ++k) run[k] = 0.f;
#pragma unroll 1
        for (int c0 = 0; c0 < 63; c0 += 9) {
            u32x4 raw[9]; float dec[9];
#pragma unroll
            for (int k = 0; k < 9; ++k) { raw[k] = *(const u32x4*)(ST + (size_t)((b * 64 + c0 + k) * 16 + h) * 8192 + off); dec[k] = CD[(b * 64 + c0 + k) * 16 + h]; }
#pragma unroll
            for (int k = 0; k < 9; ++k) { float sv[8]; unpack8(raw[k], sv);
#pragma unroll
                for (int q = 0; q < 8; ++q) run[q] = run[q] * dec[k] + sv[q];
                *(u32x4*)(ST + (size_t)((b * 64 + c0 + k) * 16 + h) * 8192 + off) = pack8(run); }
        }
    }
}

__device__ __forceinline__ void ssd_pass_c(const Params& P, LAS unsigned char* lds, int unit) {
    const int tid = threadIdx.x, lane = tid & 63, w = __builtin_amdgcn_readfirstlane(tid >> 6), g = lane >> 4, i = lane & 15;
    const int grp = unit & 1, c = (unit >> 1) & 63, b = unit >> 7, t0 = c * 64, h = grp * 8 + w;
    const bf16_t* proj = (const bf16_t*)(P.ws + WS_PROJ);
    const bf16_t* xbc = proj + (size_t)(b * T) * NPROJ + C_XBC;
    LAS bf16_t* XT = (LAS bf16_t*)lds; LAS bf16_t* Bn = (LAS bf16_t*)(lds + 73728); LAS bf16_t* Cn = (LAS bf16_t*)(lds + 91136);
    LAS float* CB = (LAS float*)(lds + 108544); LAS float* ACUM = (LAS float*)(lds + 125952); LAS float* DTV = (LAS float*)(lds + 128000); LAS float* SSQ = (LAS float*)(lds + 130048);
    const float dtraw = ssd_dt_load(P, b, t0, h, lane);
    __syncthreads();
    { const int cgi = tid & 63, lseg = tid >> 6; u32x4 o[8]; conv_item<true>(xbc, t0 + 8 * lseg, grp * 512 + 8 * cgi, P.in[3], P.in[4], o);
#pragma unroll
      for (int e = 0; e < 8; ++e) *(LAS u32x4*)(XT + (8 * cgi + e) * 72 + 8 * lseg) = o[e]; }
    if (tid < 256) { const int cgi = tid & 31, lseg = tid >> 5; const int isC = cgi >> 4, cc = cgi & 15; u32x4 o[8];
      conv_item<false>(xbc, t0 + 8 * lseg, 1024 + isC * 256 + grp * 128 + 8 * cc, P.in[3], P.in[4], o);
      LAS bf16_t* dst = (isC ? Cn : Bn) + (8 * lseg) * 136 + 8 * cc;
#pragma unroll
      for (int l = 0; l < 8; ++l) *(LAS u32x4*)(dst + l * 136) = o[l]; }
    { float dt, acum, atot; ssd_dt(P, dtraw, h, lane, dt, acum, atot); ACUM[w * 64 + lane] = acum; DTV[w * 64 + lane] = dt; }
    u32x4 pfr[4][4];
    if (c > 0) { const bf16_t* prev = (const bf16_t*)P.out + (size_t)((b * 64 + c - 1) * 16 + h) * 8192;
#pragma unroll
        for (int pt = 0; pt < 4; ++pt)
#pragma unroll
            for (int ks = 0; ks < 4; ++ks) pfr[pt][ks] = *(const u32x4*)(prev + (16 * pt + i) * 128 + 32 * ks + 8 * g); }
    __syncthreads();
    { const int lt = w >> 1;
#pragma unroll
      for (int q = 0; q < 2; ++q) { const int st = (w & 1) * 2 + q; f32x4 cacc = (f32x4){0.f, 0.f, 0.f, 0.f};
#pragma unroll
        for (int ks = 0; ks < 4; ++ks) { const bf16x8 af = *(const LAS bf16x8*)(Cn + (16 * lt + i) * 136 + 32 * ks + 8 * g), bfr = *(const LAS bf16x8*)(Bn + (16 * st + i) * 136 + 32 * ks + 8 * g); cacc = mfma16(af, bfr, cacc); }
#pragma unroll
        for (int r = 0; r < 4; ++r) CB[(16 * lt + 4 * g + r) * 68 + 16 * st + i] = cacc[r]; } }
    u32x2 zreg[4][4];
#pragma unroll
    for (int lt = 0; lt < 4; ++lt) { const bf16_t* zrow = proj + (size_t)(b * T + t0 + 16 * lt + i) * NPROJ + C_Z + h * 64 + 4 * g;
#pragma unroll
        for (int pt = 0; pt < 4; ++pt) zreg[lt][pt] = *(const u32x2*)(zrow + 16 * pt); }
    __syncthreads();
    f32x4 acc[4][4];
#pragma unroll
    for (int lt = 0; lt < 4; ++lt)
#pragma unroll
        for (int pt = 0; pt < 4; ++pt) acc[lt][pt] = (f32x4){0.f, 0.f, 0.f, 0.f};
    if (c > 0) {
#pragma unroll
        for (int pt = 0; pt < 4; ++pt)
#pragma unroll
            for (int ks = 0; ks < 4; ++ks) { const bf16x8 pf_ = as_frag(pfr[pt][ks]);
#pragma unroll
                for (int lt = 0; lt < 4; ++lt) { const bf16x8 cf = *(const LAS bf16x8*)(Cn + (16 * lt + i) * 136 + 32 * ks + 8 * g); acc[lt][pt] = mfma16(pf_, cf, acc[lt][pt]); } }
#pragma unroll
        for (int lt = 0; lt < 4; ++lt) { const float sc = __expf(ACUM[w * 64 + 16 * lt + i]);
#pragma unroll
            for (int pt = 0; pt < 4; ++pt) acc[lt][pt] = acc[lt][pt] * sc; }
    }
    const float dsk = P.in[7][h];
#pragma unroll
    for (int lt = 0; lt < 4; ++lt)
#pragma unroll
        for (int ks2 = 0; ks2 < 2; ++ks2) {
            if (32 * ks2 <= 16 * lt + 15) {
                const int l = 16 * lt + i; const float al = ACUM[w * 64 + l];
                const f32x4 c0 = *(const LAS f32x4*)(CB + l * 68 + 32 * ks2 + 8 * g), c1 = *(const LAS f32x4*)(CB + l * 68 + 32 * ks2 + 8 * g + 4);
                const f32x4 a0 = *(const LAS f32x4*)(ACUM + w * 64 + 32 * ks2 + 8 * g), a1 = *(const LAS f32x4*)(ACUM + w * 64 + 32 * ks2 + 8 * g + 4);
                const f32x4 d0 = *(const LAS f32x4*)(DTV + w * 64 + 32 * ks2 + 8 * g), d1 = *(const LAS f32x4*)(DTV + w * 64 + 32 * ks2 + 8 * g + 4);
                float v[8];
#pragma unroll
                for (int e = 0; e < 8; ++e) { const int sidx = 32 * ks2 + 8 * g + e; const float cbv = e < 4 ? c0[e & 3] : c1[e & 3], as = e < 4 ? a0[e & 3] : a1[e & 3], ds = e < 4 ? d0[e & 3] : d1[e & 3];
                    v[e] = (sidx <= l) ? cbv * __expf(fminf(al - as, 0.f)) * ds : 0.f;
                    if (sidx == l) v[e] += dsk; }
                const bf16x8 mf = as_frag(pack8(v));
#pragma unroll
                for (int pt = 0; pt < 4; ++pt) { const bf16x8 xf = *(const LAS bf16x8*)(XT + (w * 64 + 16 * pt + i) * 72 + 32 * ks2 + 8 * g); acc[lt][pt] = mfma16(xf, mf, acc[lt][pt]); }
            }
        }
#pragma unroll
    for (int lt = 0; lt < 4; ++lt) { const int l = 16 * lt + i; float rss = 0.f;
#pragma unroll
        for (int pt = 0; pt < 4; ++pt) { const u32x2 zr = zreg[lt][pt];
            const float z[4] = {bflo(zr.x), bfhi(zr.x), bflo(zr.y), bfhi(zr.y)};
#pragma unroll
            for (int r = 0; r < 4; ++r) { const float y = acc[lt][pt][r] * siluf(z[r]); acc[lt][pt][r] = y; rss += y * y; } }
        rss += __shfl_xor(rss, 16); rss += __shfl_xor(rss, 32);
        if (g == 0) SSQ[w * 64 + l] = rss; }
    __syncthreads();
    bf16_t* Y = (bf16_t*)(P.ws + WS_Y);
    const float* nw = P.in[8] + h * 64;
    f32x4 nwv[4];
#pragma unroll
    for (int pt = 0; pt < 4; ++pt) nwv[pt] = *(const f32x4*)(nw + 16 * pt + 4 * g);
#pragma unroll
    for (int lt = 0; lt < 4; ++lt) { const int l = 16 * lt + i; float tot = 0.f;
#pragma unroll
        for (int ww = 0; ww < 8; ++ww) tot += SSQ[ww * 64 + l];
        const float rs = rsqrtf(tot * (1.0f / 512.0f) + EPS);
        bf16_t* yrow = Y + (size_t)(b * T + t0 + l) * NMIX + h * 64 + 4 * g;
#pragma unroll
        for (int pt = 0; pt < 4; ++pt) { const f32x4 n4 = nwv[pt]; const f32x4 v = acc[lt][pt] * rs * n4;
            u32x2 pkd; pkd.x = pk2(v[0], v[1]); pkd.y = pk2(v[2], v[3]); *(u32x2*)(yrow + 16 * pt) = pkd; } }
}

__device__ __forceinline__ void swa_phase(const Params& P, LAS unsigned char* lds, int G) {
    constexpr int KP = 72, VP = 80, BUF = 64 * KP * 2 + 64 * VP * 2;
    const int tid = threadIdx.x, lane = tid & 63, w = __builtin_amdgcn_readfirstlane(tid >> 6), g = lane >> 4, i = lane & 15;
    const int krow = tid >> 3, kseg = tid & 7, half = w >> 2;
    u32x4 kr[4], vr[4], qr[4][2];
#define SWA_LOAD(uu) do { const int qb_ = (uu) & 31, kvh_ = ((uu) >> 5) & 3, b_ = (uu) >> 7; const bf16_t* proj_ = (const bf16_t*)(P.ws + WS_PROJ) + (size_t)(b_ * T) * NPROJ; \
        const bf16_t* Kg_ = proj_ + C_K + kvh_ * 64; const bf16_t* Vg_ = proj_ + C_V + kvh_ * 64; const int jlo_ = (2 * qb_ - 2 > 0) ? 2 * qb_ - 2 : 0, jhi_ = 2 * qb_ + 1; \
        _Pragma("unroll") for (int t = 0; t < 4; ++t) if (jlo_ + t <= jhi_) { kr[t] = *(const u32x4*)(Kg_ + (size_t)((jlo_ + t) * 64 + krow) * NPROJ + 8 * kseg); vr[t] = *(const u32x4*)(Vg_ + (size_t)((jlo_ + t) * 64 + krow) * NPROJ + 8 * kseg); } \
        const bf16_t* qrow_ = proj_ + (size_t)(qb_ * 128 + 16 * w + i) * NPROJ + C_Q + kvh_ * 256; \
        _Pragma("unroll") for (int a = 0; a < 4; ++a) { qr[a][0] = *(const u32x4*)(qrow_ + a * 64 + 8 * g); qr[a][1] = *(const u32x4*)(qrow_ + a * 64 + 32 + 8 * g); } } while (0)
    int u = blockIdx.x;
    if (u < 1024) SWA_LOAD(u);
    for (; u < 1024; u += G) {
        const int qb = u & 31, kvh = (u >> 5) & 3, b = u >> 7;
        const int jlo = (2 * qb - 2 > 0) ? 2 * qb - 2 : 0, jhi = 2 * qb + 1;
        int wlo = 2 * qb - 2 + half; if (wlo < 0) wlo = 0; const int whi = 2 * qb + half;
        __syncthreads();
#pragma unroll
        for (int t = 0; t < 4; ++t) if (jlo + t <= jhi) { *(LAS u32x4*)(lds + t * BUF + (krow * KP + 8 * kseg) * 2) = kr[t]; *(LAS u32x4*)(lds + t * BUF + 64 * KP * 2 + (krow * VP + 8 * kseg) * 2) = vr[t]; }
        u32x4 qc[4][2];
#pragma unroll
        for (int a = 0; a < 4; ++a) { qc[a][0] = qr[a][0]; qc[a][1] = qr[a][1]; asm volatile("" : "+v"(qc[a][0]), "+v"(qc[a][1])); }
        __syncthreads();
        if (u + G < 1024) SWA_LOAD(u + G);
        const int qrel = qb * 128 + 16 * w + i;
#pragma unroll
        for (int pr = 0; pr < 2; ++pr) {
            const int h0 = kvh * 4 + pr * 2;
            bf16x8 qf[2][2]; f32x4 acc[2][4]; float lrun[2], slope2v[2];
#pragma unroll
            for (int a = 0; a < 2; ++a) { const int h = h0 + a; qf[a][0] = as_frag(qc[2 * pr + a][0]); qf[a][1] = as_frag(qc[2 * pr + a][1]);
                slope2v[a] = exp2f(-0.5f * (float)(h + 1)) * LOG2E; lrun[a] = (g == 0) ? exp2f(P.in[11][h] * LOG2E) : 0.f;
#pragma unroll
                for (int dt = 0; dt < 4; ++dt) acc[a][dt] = (f32x4){0.f, 0.f, 0.f, 0.f}; }
            for (int j = wlo; j <= whi; ++j) attn_tile<2, 1, 64>(lds + (j - jlo) * BUF, qf, acc, lrun, slope2v, qrel, j, j == whi, g, i);
            bf16_t* orow = (bf16_t*)(P.ws + WS_Y) + (size_t)(b * T + qb * 128 + 16 * w + i) * NMIX + 1024 + h0 * 64;
#pragma unroll
            for (int a = 0; a < 2; ++a) { float l = lrun[a]; l += __shfl_xor(l, 16); l += __shfl_xor(l, 32); const float i0 = 1.0f / l;
#pragma unroll
                for (int dt = 0; dt < 4; ++dt) { const f32x4 v = acc[a][dt] * i0; u32x2 pkd; pkd.x = pk2(v[0], v[1]); pkd.y = pk2(v[2], v[3]); *(u32x2*)(orow + a * 64 + 16 * dt + 4 * g) = pkd; } }
        }
    }
#undef SWA_LOAD
}
__device__ __forceinline__ void diff_phase_unit(const Params& P, LAS unsigned char* lds, int bh, int qb, float lam, float thr2) {
    const int w = __builtin_amdgcn_readfirstlane(threadIdx.x >> 6);
    const int h = bh & 7, b = bh >> 3;
    const bf16_t* qkv = (const bf16_t*)(P.ws + WS_PROJ) + (size_t)(b * T) * NQKV;
    bf16_t* O = (bf16_t*)(P.ws + WS_Y) + (size_t)(b * T + qb * 128) * D + h * 128;
    const int half = w >> 2;
    const float sl = exp2f(-(float)(h + 1)) * LOG2E;
    const float slope2v[2] = {sl, sl}, linit[2] = {0.f, 0.f};
    const float lam_init = 0.8f - 0.6f * 0.7408182206817179f;
    const float dreq = thr2 / sl;
    const int kb = (dreq < 8192.f) ? (int)floorf((dreq + 63.0f) * (1.0f / 64.0f)) + 1 : 1 << 20;
    int jlo = 2 * qb - kb + 1; if (jlo < 0) jlo = 0;
    int wlo = 2 * qb + half - kb + 1; if (wlo < 0) wlo = 0;
    attn_unit<2, 2, 128>(lds, qkv + (size_t)(qb * 128) * NQKV + h * 128, qkv + 1024 + h * 128, qkv + 2048 + h * 128, NQKV,
                         qb * 128, jlo, 2 * qb + 1, wlo, 2 * qb + half, slope2v, linit, O, D, lam, P.in[21], 1.0f - lam_init);
}

typedef __attribute__((address_space(1))) unsigned gu32;
constexpr size_t WS_BAR = 576 * 1024;
constexpr int LDS_MISC = 147456 - 64;
#define XB_TMO      128
#define XB_XCNT(j)  (256  + 64 * (j))
#define XB_XSUB(j)  (1280 + 64 * (j))
#define XB_XGEN(j)  (2304 + 64 * (j))
#define XB_TOP      3328
#define XB_TOPGEN   3392
#define XCD_BAR_WORDS 3456
#define XB_SPIN_CAP (1u << 23)

__device__ __forceinline__ unsigned xb_ld(unsigned* p)              { return __hip_atomic_load(p, __ATOMIC_RELAXED, __HIP_MEMORY_SCOPE_AGENT); }
__device__ __forceinline__ unsigned xb_add(unsigned* p, unsigned v) { return __hip_atomic_fetch_add(p, v, __ATOMIC_RELAXED, __HIP_MEMORY_SCOPE_AGENT); }
__device__ __forceinline__ unsigned xb_xcc_id() { return (unsigned)__builtin_amdgcn_s_getreg((3 << 11) | 20) & 0xFu; }
#define XB_SPIN(cond, bar) do { unsigned _sp = 0; while (cond) { __builtin_amdgcn_s_sleep(1); \
    if ((++_sp & 255u) == 0u) { if (xb_ld(&(bar)[XB_TMO])) break; if (_sp > XB_SPIN_CAP) { atomicAdd(&(bar)[XB_TMO], 1u); break; } } } } while (0)

struct XcdBarrier {
    unsigned* bar; unsigned x;
    volatile LAS unsigned* st;
};

__device__ __forceinline__ XcdBarrier xcd_barrier_post(unsigned* bar, volatile LAS unsigned* st) {
    XcdBarrier b; b.bar = bar; b.x = xb_xcc_id(); b.st = st;
    if (threadIdx.x == 0) (void)xb_add(&bar[XB_XCNT(b.x)], 1u);
    return b;
}
__device__ __forceinline__ void xcd_barrier_complete(unsigned* bar, unsigned x, unsigned& nloc, unsigned& nx) {
    const unsigned G = gridDim.x * gridDim.y * gridDim.z;
    unsigned sum, cnt, mine, sp = 0u;
    for (;;) {
        sum = 0u; cnt = 0u; mine = 0u;
#pragma unroll
        for (unsigned j = 0; j < 16; ++j) { const unsigned c = xb_ld(&bar[XB_XCNT(j)]); sum += c; cnt += (c > 0u) ? 1u : 0u; mine = (j == x) ? c : mine; }
        if (sum == G) break;
        __builtin_amdgcn_s_sleep(1);
        if ((++sp & 255u) == 0u) { if (xb_ld(&bar[XB_TMO])) break; if (sp > XB_SPIN_CAP) { atomicAdd(&bar[XB_TMO], 1u); break; } }
    }
    nloc = mine > 0u ? mine : 1u; nx = cnt > 0u ? cnt : 1u;
}

__device__ __forceinline__ void xcd_barrier(const XcdBarrier& b) {
    asm volatile("s_waitcnt vmcnt(0)" ::: "memory");
    __syncthreads();
    if (threadIdx.x == 0) {
        unsigned* bar = b.bar;
        __builtin_amdgcn_s_waitcnt(0);
        unsigned nloc = b.st[0], nx = b.st[1];
        if (nloc == 0u) { xcd_barrier_complete(bar, b.x, nloc, nx); b.st[0] = nloc; b.st[1] = nx; }
        const unsigned old = xb_add(&bar[XB_XSUB(b.x)], 1u);
        const unsigned gen = old / nloc;
        if (old + 1u == (gen + 1u) * nloc) {
            __builtin_amdgcn_fence(__ATOMIC_RELEASE, "agent");
            asm volatile("s_waitcnt vmcnt(0)" ::: "memory");
            const unsigned og = xb_add(&bar[XB_TOP], 1u);
            const unsigned tg = og / nx;
            if (og + 1u == (tg + 1u) * nx) xb_add(&bar[XB_TOPGEN], 1u);
            else XB_SPIN(xb_ld(&bar[XB_TOPGEN]) == tg, bar);
            __builtin_amdgcn_fence(__ATOMIC_ACQUIRE, "agent");
            xb_add(&bar[XB_XGEN(b.x)], 1u);
            asm volatile("s_waitcnt vmcnt(0)" ::: "memory");
        } else {
            XB_SPIN(xb_ld(&bar[XB_XGEN(b.x)]) == gen, bar);
            __builtin_amdgcn_fence(__ATOMIC_ACQUIRE, "agent");
            asm volatile("s_waitcnt vmcnt(0)" ::: "memory");
        }
    }
    __syncthreads();
}

__global__ void __launch_bounds__(512) fwd_kernel(Params P) {
    extern __shared__ __attribute__((aligned(16))) unsigned char lds_raw[];
    LAS unsigned char* lds = (LAS unsigned char*)lds_raw;
    const int G = gridDim.x;
    unsigned char* ws = P.ws;
    float* ssq = (float*)(ws + WS_SSQ);
    bf16_t* XB = (bf16_t*)(ws + WS_XB);
    bf16_t* BIG = (bf16_t*)(ws + WS_PROJ);
    bf16_t* YB = (bf16_t*)(ws + WS_Y);
    const int lo = P.ph_lo, hi = P.ph_hi;
    if (threadIdx.x < 2) ((volatile LAS unsigned*)(lds + LDS_MISC))[threadIdx.x] = 0u;
    __syncthreads();
    XcdBarrier xbar; xbar.bar = (unsigned*)(ws + WS_BAR); xbar.x = 0; xbar.st = (volatile LAS unsigned*)(lds + LDS_MISC);
    if (hi - lo > 1) xbar = xcd_barrier_post((unsigned*)(ws + WS_BAR), (volatile LAS unsigned*)(lds + LDS_MISC));
    if (hi > 1000) cg::this_grid().sync();
#define IN(k) (lo <= (k) && (k) < hi)
#define SEAM(k) do { if (IN(k) && IN((k) + 1)) xcd_barrier(xbar); } while (0)
#define GEMM_STORE(ACT, NRM, Wt, NN, LDC, NCOLS, SSQ, QW, KW) do { pg8::Gemm g{XB, (const bf16_t*)(Wt), M, NN, D}; pg8::EpiStore<ACT, NRM> E{BIG, LDC, NCOLS, SSQ, (float*)(ws + WS_DT), QW, KW}; \
        pg8::StaticOrder S; S.init(M, NN, G, (int)blockIdx.x); pg8::gemm_phase<pg8::EpiStore<ACT, NRM>, pg8::StaticOrder, true, true>(lds, g, S, E); } while (0)
#define GEMM_RES(RESF, OUTF, SCALE, A, Wt, KK, SSQ, SSQIN) do { pg8::Gemm g{A, (const bf16_t*)(Wt), M, D, KK}; pg8::EpiRes<RESF, OUTF, SCALE> E{P.in[0], XB, P.out, SSQ, SSQIN}; \
        pg8::StaticOrder S; S.init(M, D, G, (int)blockIdx.x); pg8::gemm_phase<pg8::EpiRes<RESF, OUTF, SCALE>, pg8::StaticOrder, true, true>(lds, g, S, E); } while (0)
    if (IN(0)) p0_prologue(P, lds, G);
    SEAM(0);
    if (IN(1)) GEMM_STORE(0, 1, ws + WS_WIN, 4096, NPROJ, 4096, ssq, P.in[9], P.in[10]);
    SEAM(1);
    if (IN(2)) {
        for (int u = blockIdx.x; u < 1024; u += G) ssd_pass_a(P, lds, u);
        swa_phase(P, lds, G);
        __syncthreads();
    }
    SEAM(2);
    if (IN(3)) ssd_scan(P, G);
    SEAM(3);
    if (IN(4)) { for (int u = blockIdx.x; u < 1024; u += G) ssd_pass_c(P, lds, u); __syncthreads(); }
    SEAM(4);
    if (IN(5)) GEMM_RES(false, false, false, YB, ws + WS_WOE, NMIX, ssq + M, (const float*)nullptr);
    SEAM(5);
    if (IN(6)) GEMM_STORE(1, 0, ws + WS_W1, FF, FF, FF, ssq + M, (const float*)nullptr, (const float*)nullptr);
    SEAM(6);
    if (IN(7)) GEMM_RES(false, false, true, BIG, ws + WS_W2, FF, ssq + 2 * M, (const float*)(ssq + M));
    SEAM(7);
    if (IN(8)) GEMM_STORE(0, 2, ws + WS_WQKV, NQKV, NQKV, NQKV, ssq + 2 * M, P.in[15], P.in[16]);
    SEAM(8);
    if (IN(9)) {
        float l1 = 0.f, l2 = 0.f;
        for (int e = 0; e < 64; ++e) { l1 += P.in[17][e] * P.in[18][e]; l2 += P.in[19][e] * P.in[20][e]; }
        const float lam = __expf(l1) - __expf(l2) + (0.8f - 0.6f * 0.7408182206817179f);
        float mq = 0.f, mk = 0.f;
        for (int e = 0; e < 64; ++e) { mq = fmaxf(mq, fabsf(P.in[15][e])); mk = fmaxf(mk, fabsf(P.in[16][e])); }
        const float thr2 = 152.0f + 2.0f * (8.0f * LOG2E * mq * mk * 1.01f);
        if (G == 256) {
            const int xcd = blockIdx.x & 7, cu = blockIdx.x >> 3;
            LAS unsigned char* ord = (LAS unsigned char*)(lds + 147456 - 1024);
            __syncthreads();
            if (threadIdx.x < 256) {
                const int t = threadIdx.x; int rank = 0;
                auto work = [&](int uu) { const int hh = uu >> 5, qq = uu & 31; const float sl_ = exp2f(-(float)(hh + 1)) * LOG2E; const float dreq_ = thr2 / sl_;
                    const int kb_ = (dreq_ < 8192.f) ? (int)floorf((dreq_ + 63.0f) * (1.0f / 64.0f)) + 1 : 1 << 20; int jl = 2 * qq - kb_ + 1; if (jl < 0) jl = 0; return 2 * qq + 2 - jl; };
                const int wt = work(t);
                for (int o = 0; o < 256; ++o) { const int wo = work(o); rank += (wo > wt || (wo == wt && o < t)) ? 1 : 0; }
                ord[rank] = (unsigned char)t;
            }
            __syncthreads();
            for (int r = 0; r < 8; ++r) { const int uu = __builtin_amdgcn_readfirstlane((int)ord[r * 32 + ((r & 1) ? 31 - cu : cu)]); const int bh = xcd * 8 + (uu >> 5), qb = uu & 31; __syncthreads(); diff_phase_unit(P, lds, bh, qb, lam, thr2); }
        } else {
            const int nround = (2048 + G - 1) / G;
            for (int it = 0; it < nround; ++it) {
                int u = it * G + (int)blockIdx.x; if (u >= 2048) break;
                const int bh = u & 63; int k = u >> 6;
                const int grp4 = k >> 2, sub = k & 3; const int qb = 31 - (4 * grp4 + ((grp4 & 1) ? 3 - sub : sub));
                __syncthreads(); diff_phase_unit(P, lds, bh, qb, lam, thr2);
            }
        }
        __syncthreads();
    }
    SEAM(9);
    if (IN(10)) GEMM_RES(false, false, false, YB, ws + WS_WOO, D, ssq + 3 * M, (const float*)nullptr);
    SEAM(10);
    if (IN(11)) GEMM_STORE(1, 0, ws + WS_W1 + 8 * MiB, FF, FF, FF, ssq + 3 * M, (const float*)nullptr, (const float*)nullptr);
    SEAM(11);
    if (IN(12)) GEMM_RES(false, true, true, BIG, ws + WS_W2 + 8 * MiB, FF, (float*)nullptr, (const float*)(ssq + 3 * M));
}

extern "C" void kernel_launch(void* const* d_in, const int* in_sizes, int n_in, void* d_out, int out_size, void* d_ws, size_t ws_size, hipStream_t stream) {
    static int grid = 0;
    if (grid == 0) {
        if (n_in != 26 || out_size != M * D || ws_size < WS_END) { fprintf(stderr, "kernel_launch: unexpected problem (n_in %d, out %d, ws %zu)\n", n_in, out_size, ws_size); grid = -1; return; }
        int dev = 0, cus = 0, per_cu = 0;
        hipGetDevice(&dev); hipDeviceGetAttribute(&cus, hipDeviceAttributeMultiprocessorCount, dev);
        if (hipFuncSetAttribute((const void*)fwd_kernel, hipFuncAttributeMaxDynamicSharedMemorySize, LDS_BYTES) != hipSuccess) { fprintf(stderr, "kernel_launch: hipFuncSetAttribute failed\n"); grid = -1; return; }
        if (hipOccupancyMaxActiveBlocksPerMultiprocessor(&per_cu, (const void*)fwd_kernel, 512, LDS_BYTES) != hipSuccess || per_cu < 1) { fprintf(stderr, "kernel_launch: occupancy query says %d\n", per_cu); per_cu = 1; }
        (void)hipGetLastError();
        grid = cus * 1;
        if (grid <= 0) grid = 256;
    }
    if (grid < 0) return;
    Params p{};
    for (int i = 0; i < 26; ++i) p.in[i] = (const float*)d_in[i];
    p.out = (float*)d_out; p.ws = (unsigned char*)d_ws;
#if ONE_LAUNCH
    p.ph_lo = 0; p.ph_hi = NPHASE;
    if (hipMemsetAsync((unsigned char*)d_ws + WS_BAR, 0, XCD_BAR_WORDS * 4, stream) != hipSuccess) { fprintf(stderr, "kernel_launch: memset of the barrier words failed\n"); return; }
    void* args[] = {&p};
    hipError_t e = hipLaunchCooperativeKernel((const void*)fwd_kernel, dim3(grid), dim3(512), args, LDS_BYTES, stream);
    if (e != hipSuccess) fprintf(stderr, "cooperative launch failed: %s (grid %d)\n", hipGetErrorString(e), grid);
#else
    for (int ph = 0; ph < NPHASE; ++ph) { p.ph_lo = ph; p.ph_hi = ph + 1; hipLaunchKernelGGL(fwd_kernel, dim3(grid), dim3(512), LDS_BYTES, stream, p); }
#endif
}
```
